# Optimizing an MI355X kernel written in HIP

```python
import jax, jax.numpy as jnp
from jax import lax
import numpy as np

D_MODEL = 1024
BATCH = 16
SEQ = 4096
DEPTH = 4

CHUNK = 128
A_HEADS = 4
A_HEAD_DIM = 128
A_WIDTH = A_HEADS * A_HEAD_DIM
POOL_WINDOWS = (2, 4, 8, 16)
B_GROUP_DIM = 128
B_WIDTH = len(POOL_WINDOWS) * B_GROUP_DIM
C_WIDTH = 512
CONV_WIDTH = 3
N_BRANCH = 3
IN_SPLIT_SIZES = (A_WIDTH, A_WIDTH, B_WIDTH, C_WIDTH, C_WIDTH, C_WIDTH, N_BRANCH * D_MODEL)
IN_COLS = sum(IN_SPLIT_SIZES)
_FF_RAW = -(-8 * D_MODEL // 3)
D_FF = -(-_FF_RAW // 256) * 256
N_MOD = 6
EPS = 1e-6

kernel_name = "hybrid_gmlp_pool_conv_gated_trunk"


def rmsnorm(x, g):
    xf = x.astype(jnp.float32)
    xf = xf * lax.rsqrt(jnp.mean(xf * xf, axis=-1, keepdims=True) + EPS)
    return xf.astype(x.dtype) * g


def layernorm(x, g, b):
    xf = x.astype(jnp.float32)
    mu = jnp.mean(xf, axis=-1, keepdims=True)
    var = jnp.mean(jnp.square(xf - mu), axis=-1, keepdims=True)
    return ((xf - mu) * lax.rsqrt(var + EPS)).astype(x.dtype) * g + b


def modulate(h, shift, scale):
    return h * (1.0 + scale[:, None, :]) + shift[:, None, :]


def split_cols(z):
    parts, off = [], 0
    for n in IN_SPLIT_SIZES:
        parts.append(z[..., off:off + n])
        off += n
    return parts


def gmlp_branch(u, v, ln_g, ln_b, w_s, b_s):
    bsz, seq, _ = v.shape
    v = layernorm(v, ln_g, ln_b)
    vc = v.reshape(bsz, seq // CHUNK, CHUNK, A_HEADS, A_HEAD_DIM)
    mask = jnp.tril(jnp.ones((CHUNK, CHUNK), dtype=w_s.dtype))
    w = w_s * mask[None]
    s = jnp.einsum('hts,bnshd->bnthd', w, vc) + jnp.transpose(b_s)[None, None, :, :, None]
    return u * s.reshape(bsz, seq, A_WIDTH)


def pool_branch(xb, pool_w, pool_scale):
    bsz, seq, _ = xb.shape
    xf = xb.astype(jnp.float32)
    cs = jnp.pad(jnp.cumsum(xf, axis=1), ((0, 0), (1, 0), (0, 0)))
    pos = jnp.arange(seq)
    outs = []
    for g, win in enumerate(POOL_WINDOWS):
        sl = slice(g * B_GROUP_DIM, (g + 1) * B_GROUP_DIM)
        csg = cs[..., sl]
        lag = jnp.pad(csg, ((0, 0), (win - 1, 0), (0, 0)))[:, :seq]
        cnt = jnp.minimum(pos + 1, win).astype(jnp.float32)[None, :, None]
        outs.append((csg[:, 1:] - lag) / cnt - xf[..., sl])
    p = jnp.stack(outs, axis=2).astype(xb.dtype)
    y = jnp.einsum('bsgc,gcd->bsgd', p, pool_w).reshape(bsz, seq, B_WIDTH)
    return y * pool_scale


def conv_branch(bg, cg, h, conv_w):
    seq = h.shape[1]
    z = cg * h
    zp = jnp.pad(z, ((0, 0), (CONV_WIDTH - 1, 0), (0, 0)))
    y = conv_w[0] * zp[:, 0:seq]
    for k in range(1, CONV_WIDTH):
        y = y + conv_w[k] * zp[:, k:k + seq]
    return bg * y


def setup_inputs(seed: int = 0) -> dict:
    key = jax.random.key(seed)
    ks = jax.random.split(key, 24)
    f32 = jnp.float32
    nrm = lambda k, shape, scale: (jax.random.normal(k, shape, f32) * scale).astype(f32)
    L, D = DEPTH, D_MODEL
    return {
        "x": nrm(ks[0], (BATCH, SEQ, D), 1.0),
        "c": nrm(ks[1], (BATCH, D), 1.0),
        "w_mod": nrm(ks[2], (L, D, N_MOD * D), 0.5 * D ** -0.5),
        "b_mod": nrm(ks[3], (L, N_MOD * D), 0.02),
        "g_mix": 1.0 + nrm(ks[4], (L, D), 0.05),
        "w_in": nrm(ks[5], (L, D, IN_COLS), D ** -0.5),
        "gm_ln_g": 1.0 + nrm(ks[6], (L, A_WIDTH), 0.05),
        "gm_ln_b": nrm(ks[7], (L, A_WIDTH), 0.02),
        "gm_w_s": nrm(ks[8], (L, A_HEADS, CHUNK, CHUNK), CHUNK ** -0.5),
        "gm_b_s": 1.0 + nrm(ks[9], (L, A_HEADS, CHUNK), 0.05),
        "w_pa": nrm(ks[10], (L, A_WIDTH, D), A_WIDTH ** -0.5),
        "pool_w": nrm(ks[11], (L, len(POOL_WINDOWS), B_GROUP_DIM, B_GROUP_DIM), B_GROUP_DIM ** -0.5),
        "pool_scale": 1.0 + nrm(ks[12], (L, B_WIDTH), 0.1),
        "w_pb": nrm(ks[13], (L, B_WIDTH, D), B_WIDTH ** -0.5),
        "conv_w": nrm(ks[14], (L, CONV_WIDTH, C_WIDTH), CONV_WIDTH ** -0.5),
        "w_pc": nrm(ks[15], (L, C_WIDTH, D), C_WIDTH ** -0.5),
        "w_o": nrm(ks[16], (L, D, D), D ** -0.5),
        "g_ffn": 1.0 + nrm(ks[17], (L, D), 0.05),
        "w_13": nrm(ks[18], (L, D, 2 * D_FF), D ** -0.5),
        "w_2": nrm(ks[19], (L, D_FF, D), D_FF ** -0.5),
        "g_final": 1.0 + nrm(ks[20], (D,), 0.05),
    }


def reference(x, c, w_mod, b_mod, g_mix, w_in, gm_ln_g, gm_ln_b, gm_w_s, gm_b_s, w_pa,
              pool_w, pool_scale, w_pb, conv_w, w_pc, w_o, g_ffn, w_13, w_2, g_final):
    bsz, seq, d = x.shape
    c_act = jax.nn.silu(c)
    for l in range(DEPTH):
        mod = (c_act @ w_mod[l] + b_mod[l]).reshape(bsz, N_MOD, d)
        shift1, scale1, gate1 = mod[:, 0], mod[:, 1], mod[:, 2]
        shift2, scale2, gate2 = mod[:, 3], mod[:, 4], mod[:, 5]

        h = modulate(rmsnorm(x, g_mix[l]), shift1, scale1)
        z = h @ w_in[l]
        u_a, v_a, x_b, bg_c, cg_c, h_c, gate_logits = split_cols(z)
        y_a = gmlp_branch(jax.nn.gelu(u_a), jax.nn.gelu(v_a), gm_ln_g[l], gm_ln_b[l],
                          gm_w_s[l], gm_b_s[l]) @ w_pa[l]
        y_b = pool_branch(x_b, pool_w[l], pool_scale[l]) @ w_pb[l]
        y_c = conv_branch(bg_c, cg_c, h_c, conv_w[l]) @ w_pc[l]
        g = jax.nn.sigmoid(gate_logits).reshape(bsz, seq, N_BRANCH, d)
        merged = g[:, :, 0] * y_a + g[:, :, 1] * y_b + g[:, :, 2] * y_c
        x = x + gate1[:, None, :] * (merged @ w_o[l])

        h = modulate(rmsnorm(x, g_ffn[l]), shift2, scale2)
        ab = h @ w_13[l]
        a, b = ab[..., :D_FF], ab[..., D_FF:]
        x = x + gate2[:, None, :] * ((jax.nn.silu(a) * b) @ w_2[l])
    return rmsnorm(x, g_final)
```

```cpp
#include <hip/hip_runtime.h>
#include <hip/hip_cooperative_groups.h>
#include <cstdio>
#include <cstdint>
namespace cg = cooperative_groups;

#define LAS __attribute__((address_space(3)))
typedef unsigned short bf16_t;
typedef short bf16x8 __attribute__((ext_vector_type(8)));
typedef float f32x4 __attribute__((ext_vector_type(4)));
typedef float f32x2 __attribute__((ext_vector_type(2)));
typedef unsigned u32x4 __attribute__((ext_vector_type(4)));
typedef unsigned u32x2 __attribute__((ext_vector_type(2)));

constexpr int D = 1024, BATCH = 16, SEQ = 4096, DEPTH = 4, M = BATCH * SEQ, MH = M / 2;
constexpr int NIN = 6144, NFF = 2816, N13 = 5632, KP = 1536, NMOD = 6144, ZW = 3072;
constexpr float EPS = 1e-6f;
constexpr size_t MiB = 1u << 20;
constexpr size_t WS_ZA = 0, WS_ZG = 192 * MiB, WS_Y = 384 * MiB, WS_MG = 480 * MiB, WS_XG = 608 * MiB, WS_H = 0;
constexpr size_t WS_W = 736 * MiB;
constexpr size_t E_WIN = (size_t)NIN * D, E_WP = (size_t)D * KP, E_WO = (size_t)D * D, E_W13 = (size_t)N13 * D, E_W2 = (size_t)D * NFF;
constexpr size_t WS_WIN = WS_W, WS_WP = WS_WIN + 4 * E_WIN * 2, WS_WO = WS_WP + 4 * E_WP * 2, WS_W13 = WS_WO + 4 * E_WO * 2, WS_W2 = WS_W13 + 4 * E_W13 * 2, WS_WEND = WS_W2 + 4 * E_W2 * 2;
constexpr size_t WS_SM = 872 * MiB;
constexpr size_t WS_MOD = WS_SM, WS_GM1 = WS_MOD + (size_t)4 * 16 * NMOD * 4, WS_GM2 = WS_GM1 + (size_t)4 * 16 * D * 4, WS_SW1 = WS_GM2 + (size_t)4 * 16 * D * 4,
                 WS_SW2 = WS_SW1 + (size_t)4 * 16 * NIN * 4, WS_RSQ1 = WS_SW2 + (size_t)4 * 16 * N13 * 4, WS_RSQ2 = WS_RSQ1 + (size_t)M * 16, WS_WSM = WS_RSQ2 + (size_t)M * 16,
                 WS_END = WS_WSM + (size_t)4 * 4 * 128 * 128 * 2;
constexpr size_t WS_BAR = (WS_END + 4095) / 4096 * 4096, BAR_BYTES = 16384;
constexpr size_t WS_XF = 352 * MiB;
static_assert(WS_XF + (size_t)M * D * 4 <= WS_XG && WS_H + (size_t)M * NFF * 2 <= WS_XF, "ws map 2");
static_assert(WS_WEND <= WS_SM && WS_BAR + BAR_BYTES <= 1024 * MiB, "ws map");
static_assert(WS_H + (size_t)M * NFF * 2 <= WS_XG, "H overlay");

constexpr int LDS_BYTES = 131072 + 8192;
#ifndef REP_P0
#define REP_P0 1
#endif
#ifndef REP_P1
#define REP_P1 1
#endif
#ifndef REP_P2
#define REP_P2 1
#endif
#ifndef REP_P3
#define REP_P3 1
#endif
#ifndef REP_P4
#define REP_P4 1
#endif
#ifndef REP_P6
#define REP_P6 1
#endif
#ifndef REP_P5
#define REP_P5 1
#endif


__device__ __forceinline__ float bflo(unsigned w) { return __uint_as_float(w << 16); }
__device__ __forceinline__ float bfhi(unsigned w) { return __uint_as_float(w & 0xffff0000u); }
__device__ __forceinline__ float bf2f(bf16_t h) { return __uint_as_float(((unsigned)h) << 16); }
__device__ __forceinline__ unsigned cvt_pk_bf16(float lo, float hi) { unsigned r; asm volatile("v_cvt_pk_bf16_f32 %0, %1, %2" : "=v"(r) : "v"(lo), "v"(hi)); return r; }
__device__ __forceinline__ float fsigmoid(float x) { return __builtin_amdgcn_rcpf(1.0f + __expf(-x)); }
__device__ __forceinline__ float fsilu(float x) { return x * fsigmoid(x); }
__device__ __forceinline__ float fgelu(float x) { const float y = 1.5957691216057308f * (x + 0.044715f * x * x * x); return x * fsigmoid(y); }
constexpr float LOG2E = 1.4426950408889634f;
__device__ __forceinline__ float sig_from_e(float e) { return __builtin_amdgcn_rcpf(1.0f + e); }
__device__ __forceinline__ float wave_sum(float v) {
#pragma unroll
    for (int o = 1; o < 64; o <<= 1) v += __shfl_xor(v, o);
    return v;
}

namespace pg8 {
constexpr int BM = 256, BK = 64, HALF = 128, HTB = HALF * BK * 2, STAGE_BYTES = 8 * HTB, NXCD = 8, WGM = 4;
__host__ __device__ __forceinline__ int lds_byte(int r, int c) { const int st = (r >> 4) * 2 + (c >> 5), rr = r & 15, cc = c & 31, ob = rr * 64 + cc * 2; return st * 1024 + (ob ^ (((ob >> 9) & 1) << 5)); }
__host__ __device__ __forceinline__ void stage_rc(int b, int& R, int& C) { const int st = b / 1024, sb = b % 1024, swz = sb ^ (((sb >> 9) & 1) << 5); R = (st >> 1) * 16 + swz / 64; C = (st & 1) * 32 + (swz % 64) / 2; }
__host__ __device__ __forceinline__ int perm32(int rho) { const int n = rho >> 4, i = rho & 15; return 8 * (i >> 2) + 4 * n + (i & 3); }

struct Unit { int pm, pn, seg; };
struct Gemm { const bf16_t* A; const bf16_t* Bt; int lda, ldb, K; };

template <int NSEG> struct Order {
    int nM, nN, nwg, G, c;
    __device__ void init(int Mrows, int Ncols, int G_, int c_) { nM = Mrows / BM; nN = Ncols / BM; nwg = nM * nN; G = G_; c = c_; }
    __device__ bool next(int i, Unit& u) const {
        const int ti = i / NSEG; u.seg = i - ti * NSEG;
        const long L = (long)ti * G + c; if (L >= nwg) return false;
        int wgid = (int)L; { const int q = nwg / NXCD, r = nwg % NXCD, xcd = wgid % NXCD, off = wgid / NXCD; wgid = (xcd < r ? xcd * (q + 1) : r * (q + 1) + (xcd - r) * q) + off; }
        const int nig = WGM * nN, gid = wgid / nig, fm = gid * WGM, gsz = (nM - fm) < WGM ? (nM - fm) : WGM;
        u.pm = fm + ((wgid % nig) % gsz); u.pn = (wgid % nig) / gsz; return true;
    }
};

template <class Epi, class Sched, bool ALIGN_EPI, bool SP2>
__device__ __forceinline__ void gemm_phase(LAS unsigned char* lds, const Gemm g, const Sched& S, const Epi& E) {
    int tid = threadIdx.x; asm volatile("" : "+v"(tid));
    const int wid = __builtin_amdgcn_readfirstlane(tid >> 6), lane = tid & 63, wr = wid >> 2, wc = wid & 3, fr = lane & 15, fq = lane >> 4;
    const int K = g.K, nt = K / BK;
    unsigned voffA[2], voffB[2];
#pragma unroll
    for (int i = 0; i < 2; ++i) { int R, C; stage_rc(tid * 16 + i * 8192, R, C); const int Rb = Epi::PERM ? ((R & ~31) + perm32(R & 31)) : R;
        voffA[i] = (unsigned)(R * g.lda + C) * 2u; voffB[i] = (unsigned)(Rb * g.ldb + C) * 2u; }
    const size_t kstep = (size_t)(BK * 2);
    const size_t hstepA = (size_t)HALF * g.lda * 2, hstepB = (size_t)HALF * g.ldb * 2;
    const size_t segb = (size_t)K * 2;
    const unsigned ldsw = (unsigned)wid * 1024u;
    const int aoff = lds_byte(wr * 64 + fr, fq * 8), boff = lds_byte(wc * 32 + fr, fq * 8);
#define PG8_SA(b, h) (((b) * 2 + (h)) * HTB)
#define PG8_SB(b, h) ((4 + (b) * 2 + (h)) * HTB)
#define PG8_STAGE(bufoff, gbase, voff) do { _Pragma("unroll") for (int _i = 0; _i < 2; ++_i) \
        __builtin_amdgcn_global_load_lds((const unsigned*)((const char*)(gbase) + (voff)[_i]), (LAS unsigned*)(lds + (bufoff) + ldsw + _i * 8192), 16, 0, 0); } while (0)
#define PG8_LDA(dst, b, h) do { _Pragma("unroll") for (int m = 0; m < 4; ++m) _Pragma("unroll") for (int k = 0; k < 2; ++k) dst[m][k] = *(const LAS bf16x8*)(lds + PG8_SA(b, h) + aoff + m * 2048 + k * 1024); } while (0)
#define PG8_LDB(dst, b, h) do { _Pragma("unroll") for (int n = 0; n < 2; ++n) _Pragma("unroll") for (int k = 0; k < 2; ++k) dst[n][k] = *(const LAS bf16x8*)(lds + PG8_SB(b, h) + boff + n * 2048 + k * 1024); } while (0)
#define PG8_MMA(ai, bj, At, Bt) do { __builtin_amdgcn_s_setprio(1); _Pragma("unroll") for (int m = 0; m < 4; ++m) _Pragma("unroll") for (int n = 0; n < 2; ++n) _Pragma("unroll") for (int k = 0; k < 2; ++k) \
        acc[ai][bj][m][n] = __builtin_amdgcn_mfma_f32_16x16x32_bf16(Bt[n][k], At[m][k], acc[ai][bj][m][n], 0, 0, 0); __builtin_amdgcn_s_setprio(0); } while (0)
#define PG8_WAIT_V(n) asm volatile("s_waitcnt vmcnt(" #n ")" ::: "memory")
#define PG8_WAIT_L(n) asm volatile("s_waitcnt lgkmcnt(" #n ")" ::: "memory")
#define PG8_BAR __builtin_amdgcn_s_barrier()
#define PG8_SCHED __builtin_amdgcn_sched_barrier(0)
    Unit cur, nxt; int ui = 0;
    if (!S.next(0, cur)) return;
    f32x4 acc[2][2][4][2];
#pragma unroll
    for (int a = 0; a < 2; ++a)
#pragma unroll
        for (int b = 0; b < 2; ++b)
#pragma unroll
            for (int m = 0; m < 4; ++m)
#pragma unroll
                for (int n = 0; n < 2; ++n) acc[a][b][m][n] = (f32x4){0.f, 0.f, 0.f, 0.f};
    bf16x8 At[4][2], B0[2][2], B1[2][2];
    const char* cA = (const char*)g.A + (size_t)cur.pm * 2 * hstepA + (size_t)cur.seg * segb; const char* cB = (const char*)g.Bt + (size_t)cur.pn * 2 * hstepB + (size_t)cur.seg * segb;
    if constexpr (SP2) {
        PG8_STAGE(PG8_SB(0, 0), cB, voffB); PG8_STAGE(PG8_SB(0, 1), cB + hstepB, voffB); PG8_STAGE(PG8_SA(0, 0), cA, voffA); PG8_STAGE(PG8_SA(0, 1), cA + hstepA, voffA);
        if (wr == 1) PG8_BAR;
        PG8_WAIT_V(2); PG8_BAR;
        PG8_STAGE(PG8_SB(1, 0), cB + kstep, voffB); PG8_STAGE(PG8_SA(1, 0), cA + kstep, voffA); PG8_STAGE(PG8_SB(1, 1), cB + hstepB + kstep, voffB);
        PG8_WAIT_V(6); PG8_BAR;
    } else {
        PG8_STAGE(PG8_SB(0, 0), cB, voffB); PG8_STAGE(PG8_SA(0, 0), cA, voffA); PG8_STAGE(PG8_SB(0, 1), cB + hstepB, voffB); PG8_STAGE(PG8_SA(0, 1), cA + hstepA, voffA);
        if (wr == 1) PG8_BAR;
        PG8_WAIT_V(4); PG8_BAR;
        PG8_STAGE(PG8_SB(1, 0), cB + kstep, voffB); PG8_STAGE(PG8_SA(1, 0), cA + kstep, voffA); PG8_STAGE(PG8_SB(1, 1), cB + hstepB + kstep, voffB);
        PG8_WAIT_V(6); PG8_BAR;
    }
    for (;;) {
        const bool has_next = S.next(ui + 1, nxt);
        const char* nA = has_next ? (const char*)g.A + (size_t)nxt.pm * 2 * hstepA + (size_t)nxt.seg * segb : cA;
        const char* nB = has_next ? (const char*)g.Bt + (size_t)nxt.pn * 2 * hstepB + (size_t)nxt.seg * segb : cB;
        for (int t = 0; t < nt; t += 2) {
            const bool last = (t == nt - 2);
            const char* a1 = cA + (size_t)(t + 1) * kstep;
            const char* a2 = last ? nA : cA + (size_t)(t + 2) * kstep; const char* b2 = last ? nB : cB + (size_t)(t + 2) * kstep;
            const char* a3 = a2 + kstep; const char* b3 = b2 + kstep;
            if constexpr (SP2) {
            PG8_LDB(B0, 0, 0); PG8_LDB(B1, 0, 1); PG8_SCHED; PG8_LDA(At, 0, 0); PG8_STAGE(PG8_SA(1, 1), a1 + hstepA, voffA);
            PG8_WAIT_V(8); PG8_WAIT_L(0); PG8_BAR; PG8_MMA(0, 0, At, B0); PG8_MMA(0, 1, At, B1); PG8_BAR; PG8_SCHED;
            PG8_LDA(At, 0, 1); PG8_STAGE(PG8_SB(0, 0), b2, voffB); PG8_STAGE(PG8_SB(0, 1), b2 + hstepB, voffB); PG8_STAGE(PG8_SA(0, 0), a2, voffA);
            PG8_WAIT_V(8); PG8_WAIT_L(0); PG8_BAR; PG8_MMA(1, 0, At, B0); PG8_MMA(1, 1, At, B1); PG8_BAR; PG8_SCHED;
            PG8_LDB(B0, 1, 0); PG8_LDB(B1, 1, 1); PG8_SCHED; PG8_LDA(At, 1, 0); PG8_STAGE(PG8_SA(0, 1), a2 + hstepA, voffA);
            PG8_WAIT_V(8); PG8_WAIT_L(0); PG8_BAR; PG8_MMA(0, 0, At, B0); PG8_MMA(0, 1, At, B1); PG8_BAR; PG8_SCHED;
            PG8_LDA(At, 1, 1); PG8_STAGE(PG8_SB(1, 0), b3, voffB); PG8_STAGE(PG8_SB(1, 1), b3 + hstepB, voffB); PG8_STAGE(PG8_SA(1, 0), a3, voffA);
            PG8_WAIT_V(8); PG8_WAIT_L(0); PG8_BAR; PG8_MMA(1, 0, At, B0); PG8_MMA(1, 1, At, B1); PG8_BAR; PG8_SCHED;
            } else {
            PG8_LDB(B0, 0, 0); PG8_SCHED; PG8_LDA(At, 0, 0); PG8_STAGE(PG8_SA(1, 1), a1 + hstepA, voffA);
            PG8_WAIT_L(8); PG8_BAR; PG8_WAIT_L(0); PG8_MMA(0, 0, At, B0); PG8_BAR; PG8_SCHED;
            PG8_LDB(B1, 0, 1); PG8_STAGE(PG8_SB(0, 0), b2, voffB);
            PG8_BAR; PG8_WAIT_L(0); PG8_MMA(0, 1, At, B1); PG8_BAR;
            PG8_LDA(At, 0, 1); PG8_STAGE(PG8_SA(0, 0), a2, voffA);
            PG8_BAR; PG8_WAIT_L(0); PG8_MMA(1, 0, At, B0); PG8_BAR; PG8_SCHED;
            PG8_STAGE(PG8_SB(0, 1), b2 + hstepB, voffB);
            PG8_WAIT_V(6); PG8_BAR; PG8_MMA(1, 1, At, B1); PG8_BAR;
            PG8_LDB(B0, 1, 0); PG8_SCHED; PG8_LDA(At, 1, 0); PG8_STAGE(PG8_SA(0, 1), a2 + hstepA, voffA);
            PG8_WAIT_L(8); PG8_BAR; PG8_WAIT_L(0); PG8_MMA(0, 0, At, B0); PG8_BAR; PG8_SCHED;
            PG8_LDB(B1, 1, 1); PG8_STAGE(PG8_SB(1, 0), b3, voffB);
            PG8_BAR; PG8_WAIT_L(0); PG8_MMA(0, 1, At, B1); PG8_BAR;
            PG8_LDA(At, 1, 1); PG8_STAGE(PG8_SA(1, 0), a3, voffA);
            PG8_BAR; PG8_WAIT_L(0); PG8_MMA(1, 0, At, B0); PG8_BAR; PG8_SCHED;
            PG8_STAGE(PG8_SB(1, 1), b3 + hstepB, voffB);
            PG8_WAIT_V(6); PG8_BAR; PG8_MMA(1, 1, At, B1); PG8_BAR;
            }
        }
        if constexpr (ALIGN_EPI) { if (wr == 0) PG8_BAR; }
        E(acc, cur, wr, wc, fr, fq);
        if (!has_next) break;
        if (!Epi::ACCUM || nxt.seg == 0) {
#pragma unroll
            for (int a = 0; a < 2; ++a)
#pragma unroll
                for (int b = 0; b < 2; ++b)
#pragma unroll
                    for (int m = 0; m < 4; ++m)
#pragma unroll
                        for (int n = 0; n < 2; ++n) acc[a][b][m][n] = (f32x4){0.f, 0.f, 0.f, 0.f};
        }
        cur = nxt; cA = nA; cB = nB; ++ui;
        if constexpr (ALIGN_EPI) { if (wr == 1) PG8_BAR; }
    }
    PG8_WAIT_V(0);
    if constexpr (!ALIGN_EPI) { if (wr == 0) PG8_BAR; }
    PG8_BAR;
#undef PG8_SA
#undef PG8_SB
#undef PG8_STAGE
#undef PG8_LDA
#undef PG8_LDB
#undef PG8_MMA
#undef PG8_WAIT_V
#undef PG8_WAIT_L
#undef PG8_BAR
#undef PG8_SCHED
}
}
using pg8::Unit;

struct EpiIn {
    static constexpr bool PERM = true, ACCUM = false;
    bf16_t* ZA; bf16_t* ZG; const float* rowsq; const float* sW; int row0;
    __device__ __forceinline__ void operator()(f32x4 (&acc)[2][2][4][2], const Unit& u, int wr, int wc, int fr, int fq) const {
        const int lrow0 = u.pm * 256 + wr * 64 + fr, b = (row0 + u.pm * 256) >> 12, colin = u.pn * 256 + wc * 32 + 8 * fq;
        const float* swp = sW + b * NIN + colin;
        f32x4 sw[2][2];
#pragma unroll
        for (int bj = 0; bj < 2; ++bj)
#pragma unroll
            for (int n = 0; n < 2; ++n) sw[bj][n] = *(const f32x4*)(swp + 128 * bj + 4 * n);
        bf16_t* outp; int colo, mode;
        if (u.pn < 12) { outp = ZA; colo = colin; mode = (u.pn < 4) ? 1 : 0; } else { outp = ZG; colo = colin - ZW; mode = 2;
#pragma unroll
            for (int bj = 0; bj < 2; ++bj)
#pragma unroll
                for (int n = 0; n < 2; ++n) sw[bj][n] *= -LOG2E; }
        float rq[2][4];
#pragma unroll
        for (int ai = 0; ai < 2; ++ai)
#pragma unroll
            for (int m = 0; m < 4; ++m) { const f32x4 p = *(const f32x4*)(rowsq + (size_t)(row0 + lrow0 + ai * 128 + m * 16) * 4); rq[ai][m] = (p[0] + p[1]) + (p[2] + p[3]); }
#pragma unroll
        for (int ai = 0; ai < 2; ++ai)
#pragma unroll
            for (int m = 0; m < 4; ++m) {
                const int lr = lrow0 + ai * 128 + m * 16;
                float rs = __builtin_amdgcn_rsqf(rq[ai][m] * (1.0f / D) + EPS);
                if (mode == 2) rs *= -LOG2E;
                bf16_t* rowp = outp + (size_t)lr * ZW + colo;
#pragma unroll
                for (int bj = 0; bj < 2; ++bj) {
                    f32x4 v0 = acc[ai][bj][m][0] * rs + sw[bj][0], v1 = acc[ai][bj][m][1] * rs + sw[bj][1];
                    if (mode == 1) {
                        const float c1 = -1.5957691216057308f * LOG2E, c3 = c1 * 0.044715f;
                        const f32x4 p0 = (v0 * v0) * c3 + c1, p1 = (v1 * v1) * c3 + c1;
                        const f32x4 q0 = v0 * p0, q1 = v1 * p1;
#pragma unroll
                        for (int j = 0; j < 4; ++j) { v0[j] *= sig_from_e(__builtin_amdgcn_exp2f(q0[j])); v1[j] *= sig_from_e(__builtin_amdgcn_exp2f(q1[j])); }
                    } else if (mode == 2) {
#pragma unroll
                        for (int j = 0; j < 4; ++j) { v0[j] = sig_from_e(__builtin_amdgcn_exp2f(v0[j])); v1[j] = sig_from_e(__builtin_amdgcn_exp2f(v1[j])); }
                    }
                    u32x4 w; w.x = cvt_pk_bf16(v0[0], v0[1]); w.y = cvt_pk_bf16(v0[2], v0[3]); w.z = cvt_pk_bf16(v1[0], v1[1]); w.w = cvt_pk_bf16(v1[2], v1[3]);
                    *(u32x4*)(rowp + 128 * bj) = w;
                }
            }
    }
};

struct EpiMerge {
    static constexpr bool PERM = true, ACCUM = true;
    const bf16_t* ZG; bf16_t* MG; int row0;
    __device__ __forceinline__ void operator()(f32x4 (&acc)[2][2][4][2], const Unit& u, int wr, int wc, int fr, int fq) const {
        const int lrow0 = u.pm * 256 + wr * 64 + fr, col = u.pn * 256 + wc * 32 + 8 * fq;
        const float tiny = 1e-30f;
        const bf16_t* gp = ZG + (size_t)lrow0 * ZW + col + u.seg * 1024;
        if (u.seg < 2) {
            u32x4 gd[2][4][2], gn[4][2];
#pragma unroll
            for (int ai = 0; ai < 2; ++ai)
#pragma unroll
                for (int m = 0; m < 4; ++m)
#pragma unroll
                    for (int bj = 0; bj < 2; ++bj) gd[ai][m][bj] = *(const u32x4*)(gp + (size_t)(ai * 128 + m * 16) * ZW + 1024 + 128 * bj);
#pragma unroll
            for (int ai = 0; ai < 2; ++ai) {
#pragma unroll
                for (int m = 0; m < 4; ++m)
#pragma unroll
                    for (int bj = 0; bj < 2; ++bj) {
                        const u32x4 ga = gd[ai][m][bj];
                        f32x4 a0 = {bflo(ga.x), bfhi(ga.x), bflo(ga.y), bfhi(ga.y)}, a1 = {bflo(ga.z), bfhi(ga.z), bflo(ga.w), bfhi(ga.w)};
#pragma unroll
                        for (int j = 0; j < 4; ++j) { a0[j] = __builtin_amdgcn_rcpf(fmaxf(a0[j], tiny)); a1[j] = __builtin_amdgcn_rcpf(fmaxf(a1[j], tiny)); }
                        acc[ai][bj][m][0] *= a0; acc[ai][bj][m][1] *= a1;
                    }
                asm volatile("" ::: "memory");
                if (ai == 1) {
#pragma unroll
                    for (int m = 0; m < 4; ++m)
#pragma unroll
                        for (int bj = 0; bj < 2; ++bj) {
                            const u32x4 ga = gn[m][bj];
                            f32x4 a0 = {bflo(ga.x), bfhi(ga.x), bflo(ga.y), bfhi(ga.y)}, a1 = {bflo(ga.z), bfhi(ga.z), bflo(ga.w), bfhi(ga.w)};
#pragma unroll
                            for (int j = 0; j < 4; ++j) { a0[j] = fmaxf(a0[j], tiny); a1[j] = fmaxf(a1[j], tiny); }
                            acc[0][bj][m][0] *= a0; acc[0][bj][m][1] *= a1;
                        }
                }
#pragma unroll
                for (int m = 0; m < 4; ++m)
#pragma unroll
                    for (int bj = 0; bj < 2; ++bj) gn[m][bj] = *(const u32x4*)(gp + (size_t)(ai * 128 + m * 16) * ZW + 128 * bj);
                asm volatile("" ::: "memory");
            }
#pragma unroll
            for (int m = 0; m < 4; ++m)
#pragma unroll
                for (int bj = 0; bj < 2; ++bj) {
                    const u32x4 ga = gn[m][bj];
                    f32x4 a0 = {bflo(ga.x), bfhi(ga.x), bflo(ga.y), bfhi(ga.y)}, a1 = {bflo(ga.z), bfhi(ga.z), bflo(ga.w), bfhi(ga.w)};
#pragma unroll
                    for (int j = 0; j < 4; ++j) { a0[j] = fmaxf(a0[j], tiny); a1[j] = fmaxf(a1[j], tiny); }
                    acc[1][bj][m][0] *= a0; acc[1][bj][m][1] *= a1;
                }
        } else {
            u32x4 gv[2][4][2];
#pragma unroll
            for (int ai = 0; ai < 2; ++ai)
#pragma unroll
                for (int m = 0; m < 4; ++m)
#pragma unroll
                    for (int bj = 0; bj < 2; ++bj) gv[ai][m][bj] = *(const u32x4*)(gp + (size_t)(ai * 128 + m * 16) * ZW + 128 * bj);
#pragma unroll
            for (int ai = 0; ai < 2; ++ai)
#pragma unroll
                for (int m = 0; m < 4; ++m)
#pragma unroll
                    for (int bj = 0; bj < 2; ++bj) {
                        const u32x4 ga = gv[ai][m][bj];
                        f32x4 a0 = {bflo(ga.x), bfhi(ga.x), bflo(ga.y), bfhi(ga.y)}, a1 = {bflo(ga.z), bfhi(ga.z), bflo(ga.w), bfhi(ga.w)};
#pragma unroll
                        for (int j = 0; j < 4; ++j) { a0[j] = fmaxf(a0[j], tiny); a1[j] = fmaxf(a1[j], tiny); }
                        const f32x4 v0 = acc[ai][bj][m][0] * a0, v1 = acc[ai][bj][m][1] * a1;
                        u32x4 w; w.x = cvt_pk_bf16(v0[0], v0[1]); w.y = cvt_pk_bf16(v0[2], v0[3]); w.z = cvt_pk_bf16(v1[0], v1[1]); w.w = cvt_pk_bf16(v1[2], v1[3]);
                        *(u32x4*)(MG + (size_t)(row0 + lrow0 + ai * 128 + m * 16) * D + col + 128 * bj) = w;
                    }
        }
    }
};

struct EpiRes {
    static constexpr bool PERM = true, ACCUM = false;
    const bf16_t* xin; void* xout; bool out_bf; const float* gate; const float* gmn; float* rowsq; bf16_t* XG; LAS float* red;
    __device__ __forceinline__ void operator()(f32x4 (&acc)[2][2][4][2], const Unit& u, int wr, int wc, int fr, int fq) const {
        const int row0 = u.pm * 256 + wr * 64 + fr, b = u.pm >> 4, col0 = u.pn * 256 + wc * 32 + 8 * fq;
        float ss[2][4];
#pragma unroll
        for (int ai = 0; ai < 2; ++ai)
#pragma unroll
            for (int m = 0; m < 4; ++m) ss[ai][m] = 0.f;
#pragma unroll
        for (int bj = 0; bj < 2; ++bj) {
            const int col = col0 + 128 * bj;
            f32x4 gt[2], gm[2];
#pragma unroll
            for (int n = 0; n < 2; ++n) { gt[n] = *(const f32x4*)(gate + b * NMOD + col + 4 * n);
                gm[n] = (f32x4){0.f, 0.f, 0.f, 0.f}; if (gmn) gm[n] = *(const f32x4*)(gmn + b * D + col + 4 * n); }
#pragma unroll
            for (int ai = 0; ai < 2; ++ai) {
                u32x4 xb[4];
#pragma unroll
                for (int m = 0; m < 4; ++m) { const unsigned vo = (unsigned)((row0 + ai * 128 + m * 16) * D + col) * 2u;
                    asm volatile("global_load_dwordx4 %0, %1, %2" : "=&v"(xb[m]) : "v"(vo), "s"(xin) : "memory"); }
                asm volatile("s_waitcnt vmcnt(0)" : "+v"(xb[0]), "+v"(xb[1]), "+v"(xb[2]), "+v"(xb[3]) :: "memory");
#pragma unroll
                for (int m = 0; m < 4; ++m) {
                    const size_t off = (size_t)(row0 + ai * 128 + m * 16) * D + col;
                    const u32x4 w = xb[m];
                    f32x4 x0 = (f32x4){bflo(w.x), bfhi(w.x), bflo(w.y), bfhi(w.y)} + gt[0] * acc[ai][bj][m][0];
                    f32x4 x1 = (f32x4){bflo(w.z), bfhi(w.z), bflo(w.w), bfhi(w.w)} + gt[1] * acc[ai][bj][m][1];
                    if (out_bf) { u32x4 o; o.x = cvt_pk_bf16(x0[0], x0[1]); o.y = cvt_pk_bf16(x0[2], x0[3]); o.z = cvt_pk_bf16(x1[0], x1[1]); o.w = cvt_pk_bf16(x1[2], x1[3]);
                        *(u32x4*)((bf16_t*)xout + off) = o;
                        x0 = (f32x4){bflo(o.x), bfhi(o.x), bflo(o.y), bfhi(o.y)}; x1 = (f32x4){bflo(o.z), bfhi(o.z), bflo(o.w), bfhi(o.w)}; }
                    else { *(f32x4*)((float*)xout + off) = x0; *(f32x4*)((float*)xout + off + 4) = x1; }
                    ss[ai][m] += ((x0[0] * x0[0] + x0[1] * x0[1]) + (x0[2] * x0[2] + x0[3] * x0[3])) + ((x1[0] * x1[0] + x1[1] * x1[1]) + (x1[2] * x1[2] + x1[3] * x1[3]));
                    if (gmn) { const f32x4 g0 = x0 * gm[0], g1 = x1 * gm[1]; u32x4 o; o.x = cvt_pk_bf16(g0[0], g0[1]); o.y = cvt_pk_bf16(g0[2], g0[3]); o.z = cvt_pk_bf16(g1[0], g1[1]); o.w = cvt_pk_bf16(g1[2], g1[3]);
                        *(u32x4*)(XG + off) = o; }
                }
                asm volatile("" ::: "memory");
            }
            asm volatile("" ::: "memory");
        }
#pragma unroll
        for (int ai = 0; ai < 2; ++ai)
#pragma unroll
            for (int m = 0; m < 4; ++m) {
                float s = ss[ai][m]; s += __shfl_xor(s, 16); s += __shfl_xor(s, 32);
                if (fq == 0) red[wc * 256 + ai * 128 + wr * 64 + m * 16 + fr] = s;
            }
        asm volatile("s_waitcnt lgkmcnt(0)" ::: "memory"); __builtin_amdgcn_s_barrier(); asm volatile("" ::: "memory");
        { const int t = (wr * 4 + wc) * 64 + fq * 16 + fr;
          if (t < 256) rowsq[(size_t)(u.pm * 256 + t) * 4 + u.pn] = (red[t] + red[256 + t]) + (red[512 + t] + red[768 + t]); }
        asm volatile("s_waitcnt lgkmcnt(0)" ::: "memory"); __builtin_amdgcn_s_barrier(); asm volatile("" ::: "memory");
    }
};

struct EpiFfn {
    static constexpr bool PERM = true, ACCUM = false;
    bf16_t* H; const float* rowsq; const float* sW;
    __device__ __forceinline__ void operator()(f32x4 (&acc)[2][2][4][2], const Unit& u, int wr, int wc, int fr, int fq) const {
        const int row0 = u.pm * 256 + wr * 64 + fr, b = u.pm >> 4, colp = u.pn * 256 + wc * 32 + 8 * fq, hcol = u.pn * 128 + wc * 32 + 8 * fq;
        const float* swp = sW + b * N13 + colp;
        f32x4 sa[2], sb[2];
#pragma unroll
        for (int n = 0; n < 2; ++n) { sa[n] = *(const f32x4*)(swp + 4 * n); sb[n] = *(const f32x4*)(swp + 128 + 4 * n); }
        float rq[2][4];
#pragma unroll
        for (int ai = 0; ai < 2; ++ai)
#pragma unroll
            for (int m = 0; m < 4; ++m) { const f32x4 p = *(const f32x4*)(rowsq + (size_t)(row0 + ai * 128 + m * 16) * 4); rq[ai][m] = (p[0] + p[1]) + (p[2] + p[3]); }
#pragma unroll
        for (int ai = 0; ai < 2; ++ai)
#pragma unroll
            for (int m = 0; m < 4; ++m) {
                const int r = row0 + ai * 128 + m * 16;
                const float rs = __builtin_amdgcn_rsqf(rq[ai][m] * (1.0f / D) + EPS);
                f32x4 h[2];
#pragma unroll
                for (int n = 0; n < 2; ++n) {
                    const f32x4 a = acc[ai][0][m][n] * rs + sa[n], bb = acc[ai][1][m][n] * rs + sb[n];
#pragma unroll
                    for (int j = 0; j < 4; ++j) h[n][j] = (a[j] * bb[j]) * sig_from_e(__builtin_amdgcn_exp2f(a[j] * -LOG2E));
                }
                u32x4 w; w.x = cvt_pk_bf16(h[0][0], h[0][1]); w.y = cvt_pk_bf16(h[0][2], h[0][3]); w.z = cvt_pk_bf16(h[1][0], h[1][1]); w.w = cvt_pk_bf16(h[1][2], h[1][3]);
                *(u32x4*)(H + (size_t)r * NFF + hcol) = w;
            }
    }
};


#define XB_TMO      128
#define XB_XCNT(j)  (256  + 64 * (j))
#define XB_XSUB(j)  (1280 + 64 * (j))
#define XB_XGEN(j)  (2304 + 64 * (j))
#define XB_TOP      3328
#define XB_TOPGEN   3392
#define XCD_BAR_WORDS 3456
#define XB_SPIN_CAP (1u << 22)
__device__ __forceinline__ unsigned xb_ld(unsigned* p)              { return __hip_atomic_load(p, __ATOMIC_RELAXED, __HIP_MEMORY_SCOPE_AGENT); }
__device__ __forceinline__ unsigned xb_add(unsigned* p, unsigned v) { return __hip_atomic_fetch_add(p, v, __ATOMIC_RELAXED, __HIP_MEMORY_SCOPE_AGENT); }
__device__ __forceinline__ unsigned xb_xcc_id() { return (unsigned)__builtin_amdgcn_s_getreg((3 << 11) | 20) & 0xFu; }
#define XB_SPIN(cond, bar) do { unsigned _sp = 0; while (cond) { __builtin_amdgcn_s_sleep(1); \
    if ((++_sp & 255u) == 0u) { if (xb_ld(&(bar)[XB_TMO])) break; if (_sp > XB_SPIN_CAP) { atomicAdd(&(bar)[XB_TMO], 1u); break; } } } } while (0)
struct XcdBarrier { unsigned* bar; unsigned x; volatile LAS unsigned* st; };
__device__ __forceinline__ XcdBarrier xcd_barrier_post(unsigned* bar, volatile LAS unsigned* st) {
    XcdBarrier b; b.bar = bar; b.x = xb_xcc_id(); b.st = st;
    if (threadIdx.x == 0) (void)xb_add(&bar[XB_XCNT(b.x)], 1u);
    return b;
}
__device__ __forceinline__ void xcd_barrier_complete(unsigned* bar, unsigned x, unsigned& nloc, unsigned& nx) {
    const unsigned G = gridDim.x * gridDim.y * gridDim.z;
    unsigned sum, cnt, mine, sp = 0u;
    for (;;) {
        sum = 0u; cnt = 0u; mine = 0u;
#pragma unroll
        for (unsigned j = 0; j < 16; ++j) { const unsigned c = xb_ld(&bar[XB_XCNT(j)]); sum += c; cnt += (c > 0u) ? 1u : 0u; mine = (j == x) ? c : mine; }
        if (sum == G) break;
        __builtin_amdgcn_s_sleep(1);
        if ((++sp & 255u) == 0u) { if (xb_ld(&bar[XB_TMO])) break; if (sp > XB_SPIN_CAP) { atomicAdd(&bar[XB_TMO], 1u); break; } }
    }
    nloc = mine > 0u ? mine : 1u; nx = cnt > 0u ? cnt : 1u;
}
__device__ __forceinline__ void xcd_barrier(const XcdBarrier& b) {
    asm volatile("s_waitcnt vmcnt(0)" ::: "memory");
    __syncthreads();
    if (threadIdx.x == 0) {
        unsigned* bar = b.bar;
        __builtin_amdgcn_s_waitcnt(0);
        unsigned nloc = b.st[0], nx = b.st[1];
        if (nloc == 0u) { xcd_barrier_complete(bar, b.x, nloc, nx); b.st[0] = nloc; b.st[1] = nx; }
        const unsigned old = xb_add(&bar[XB_XSUB(b.x)], 1u);
        const unsigned gen = old / nloc;
        if (old + 1u == (gen + 1u) * nloc) {
            __builtin_amdgcn_fence(__ATOMIC_RELEASE, "agent");
            asm volatile("s_waitcnt vmcnt(0)" ::: "memory");
            const unsigned og = xb_add(&bar[XB_TOP], 1u);
            const unsigned tg = og / nx;
            if (og + 1u == (tg + 1u) * nx) xb_add(&bar[XB_TOPGEN], 1u);
            else XB_SPIN(xb_ld(&bar[XB_TOPGEN]) == tg, bar);
            __builtin_amdgcn_fence(__ATOMIC_ACQUIRE, "agent");
            xb_add(&bar[XB_XGEN(b.x)], 1u);
            asm volatile("s_waitcnt vmcnt(0)" ::: "memory");
        } else {
            XB_SPIN(xb_ld(&bar[XB_XGEN(b.x)]) == gen, bar);
            __builtin_amdgcn_fence(__ATOMIC_ACQUIRE, "agent");
            asm volatile("s_waitcnt vmcnt(0)" ::: "memory");
        }
    }
    __syncthreads();
}

struct Args { const float* in[21]; float* out; unsigned char* ws; };
enum { I_X = 0, I_C, I_WMOD, I_BMOD, I_GMIX, I_WIN, I_LNG, I_LNB, I_WS, I_BS, I_WPA, I_POOLW, I_POOLS, I_WPB, I_CONVW, I_WPC, I_WO, I_GFFN, I_W13, I_W2, I_GFINAL };

__device__ __forceinline__ void transpose_item(const float* W, int ldw, int k0, int n0, bf16_t* dst, int ldd, int drow0, int dk0, LAS float* scr, int lane) {
    float tv[32];
    const float* wsrc = W + (size_t)(k0 + (lane >> 5)) * ldw + n0 + (lane & 31);
#pragma unroll
    for (int i = 0; i < 32; ++i) tv[i] = wsrc[(size_t)(2 * i) * ldw];
#pragma unroll
    for (int i = 0; i < 32; ++i) { const int kk = 2 * i + (lane >> 5); scr[kk * 33 + (lane & 31)] = tv[i]; }
    asm volatile("s_waitcnt vmcnt(0) lgkmcnt(0)" ::: "memory");
    const int c = lane & 7;
#pragma unroll
    for (int j = 0; j < 4; ++j) { const int n = (lane >> 3) + 8 * j; const LAS float* s = scr + (8 * c) * 33 + n;
        u32x4 o; o.x = cvt_pk_bf16(s[0 * 33], s[1 * 33]); o.y = cvt_pk_bf16(s[2 * 33], s[3 * 33]); o.z = cvt_pk_bf16(s[4 * 33], s[5 * 33]); o.w = cvt_pk_bf16(s[6 * 33], s[7 * 33]);
        *(u32x4*)(dst + (size_t)(drow0 + n) * ldd + dk0 + k0 + 8 * c) = o; }
    asm volatile("s_waitcnt lgkmcnt(0)" ::: "memory");
}

__device__ __forceinline__ void gemv64(const LAS float* vT, LAS float* red, const float* W, int ldw, int n0, int wave, int lane, int tid, float (&res)[2]) {
    float acc[16];
#pragma unroll
    for (int b = 0; b < 16; ++b) acc[b] = 0.f;
    const float* wp = W + (size_t)(wave * 128) * ldw + n0 + lane;
    const LAS f32x4* vp = (const LAS f32x4*)(vT + wave * 128 * 16);
#pragma unroll 16
    for (int kk = 0; kk < 128; ++kk) {
        const float wv = wp[(size_t)kk * ldw];
        const f32x4 v0 = vp[kk * 4 + 0], v1 = vp[kk * 4 + 1], v2 = vp[kk * 4 + 2], v3 = vp[kk * 4 + 3];
        acc[0] += v0[0] * wv; acc[1] += v0[1] * wv; acc[2] += v0[2] * wv; acc[3] += v0[3] * wv;
        acc[4] += v1[0] * wv; acc[5] += v1[1] * wv; acc[6] += v1[2] * wv; acc[7] += v1[3] * wv;
        acc[8] += v2[0] * wv; acc[9] += v2[1] * wv; acc[10] += v2[2] * wv; acc[11] += v2[3] * wv;
        acc[12] += v3[0] * wv; acc[13] += v3[1] * wv; acc[14] += v3[2] * wv; acc[15] += v3[3] * wv;
    }
#pragma unroll
    for (int b = 0; b < 16; ++b) red[(wave * 16 + b) * 64 + lane] = acc[b];
    __syncthreads();
#pragma unroll
    for (int r = 0; r < 2; ++r) { const int idx = tid + 512 * r, b = idx >> 6, n = idx & 63; float s = 0.f;
#pragma unroll
        for (int w = 0; w < 8; ++w) s += red[(w * 16 + b) * 64 + n];
        res[r] = s; }
    __syncthreads();
}

__global__ void __launch_bounds__(512, 2) fwd_megakernel(Args a) {
    extern __shared__ __attribute__((aligned(16))) unsigned char lds_raw[];
    LAS unsigned char* lds = (LAS unsigned char*)lds_raw;
    cg::grid_group grid = cg::this_grid();
    int tid, lane, wave, gw; const int G = gridDim.x, bid = blockIdx.x, NGW = G * 8;
#define RELOAD_IDS() do { tid = threadIdx.x; asm volatile("" : "+v"(tid)); lane = tid & 63; wave = __builtin_amdgcn_readfirstlane(tid >> 6); gw = bid * 8 + wave; } while (0)
    RELOAD_IDS();
    unsigned char* ws = a.ws;
    volatile LAS unsigned* MISC = (volatile LAS unsigned*)(lds + 131072);
    if (tid < 64) MISC[tid] = 0u;
    __syncthreads();
    const XcdBarrier xbar = xcd_barrier_post((unsigned*)(ws + WS_BAR), MISC + 8);
#define GRID_SYNC() xcd_barrier(xbar)

    bf16_t* ZA = (bf16_t*)(ws + WS_ZA); bf16_t* ZG = (bf16_t*)(ws + WS_ZG); bf16_t* Y = (bf16_t*)(ws + WS_Y); bf16_t* MG = (bf16_t*)(ws + WS_MG);
    bf16_t* XG = (bf16_t*)(ws + WS_XG); bf16_t* Hb = (bf16_t*)(ws + WS_H);
    bf16_t* WIN = (bf16_t*)(ws + WS_WIN); bf16_t* WP = (bf16_t*)(ws + WS_WP); bf16_t* WO = (bf16_t*)(ws + WS_WO); bf16_t* W13 = (bf16_t*)(ws + WS_W13); bf16_t* W2 = (bf16_t*)(ws + WS_W2);
    float* MOD = (float*)(ws + WS_MOD); float* GM1 = (float*)(ws + WS_GM1); float* GM2 = (float*)(ws + WS_GM2); float* SW1 = (float*)(ws + WS_SW1); float* SW2 = (float*)(ws + WS_SW2);
    float* RSQ1 = (float*)(ws + WS_RSQ1); float* RSQ2 = (float*)(ws + WS_RSQ2); bf16_t* WSM = (bf16_t*)(ws + WS_WSM);
    float* XF = (float*)(ws + WS_XF); bf16_t* X16 = (bf16_t*)a.out;

    for (int rep_ = 0; rep_ < REP_P0; ++rep_) {
{
        LAS float* vT = (LAS float*)lds; LAS float* red = (LAS float*)(lds + 65536);
        const float* c = a.in[I_C];
        for (int idx = tid; idx < 16 * D; idx += 512) { const int b = idx >> 10, k = idx & 1023; vT[k * 16 + b] = fsilu(c[idx]); }
        __syncthreads();
        for (int task = bid; task < 4 * 96; task += G) {
            const int l = task / 96, n0 = (task % 96) * 64;
            float res[2];
            gemv64(vT, red, a.in[I_WMOD] + (size_t)l * D * NMOD, NMOD, n0, wave, lane, tid, res);
#pragma unroll
            for (int r = 0; r < 2; ++r) { const int idx = tid + 512 * r, b = idx >> 6, n = n0 + (idx & 63);
                const float v = res[r] + a.in[I_BMOD][l * NMOD + n];
                MOD[(l * 16 + b) * NMOD + n] = v;
                if (n >= 1024 && n < 2048) GM1[(l * 16 + b) * D + n - 1024] = a.in[I_GMIX][l * D + n - 1024] * (1.0f + v);
                if (n >= 4096 && n < 5120) GM2[(l * 16 + b) * D + n - 4096] = a.in[I_GFFN][l * D + n - 4096] * (1.0f + v);
            }
        }
        __syncthreads();
        LAS float* scr = (LAS float*)(lds + wave * 16384);
        constexpr int IT_IN = 16 * 192, IT_PA = 8 * 32, IT_PC = 8 * 32, IT_O = 16 * 32, IT_13 = 16 * 176, IT_2 = 44 * 32, IT_L = IT_IN + IT_PA + IT_PC + IT_O + IT_13 + IT_2;
        for (int it = gw; it < 4 * IT_L; it += NGW) {
            const int l = it / IT_L; int r = it - l * IT_L;
            if (r < IT_IN) { const int kb = r / 192, nb = r % 192; transpose_item(a.in[I_WIN] + (size_t)l * D * NIN, NIN, kb * 64, nb * 32, WIN + l * E_WIN, D, nb * 32, 0, scr, lane); continue; } r -= IT_IN;
            if (r < IT_PA) { const int kb = r / 32, nb = r % 32; transpose_item(a.in[I_WPA] + (size_t)l * 512 * D, D, kb * 64, nb * 32, WP + l * E_WP, KP, nb * 32, 0, scr, lane); continue; } r -= IT_PA;
            if (r < IT_PC) { const int kb = r / 32, nb = r % 32; transpose_item(a.in[I_WPC] + (size_t)l * 512 * D, D, kb * 64, nb * 32, WP + l * E_WP, KP, nb * 32, 1024, scr, lane); continue; } r -= IT_PC;
            if (r < IT_O) { const int kb = r / 32, nb = r % 32; transpose_item(a.in[I_WO] + (size_t)l * D * D, D, kb * 64, nb * 32, WO + l * E_WO, D, nb * 32, 0, scr, lane); continue; } r -= IT_O;
            if (r < IT_13) { const int kb = r / 176, nb = r % 176; const int n0 = nb * 32; const int j = n0 % NFF, isb = n0 >= NFF; const int drow = (j / 128) * 256 + isb * 128 + (j % 128);
                transpose_item(a.in[I_W13] + (size_t)l * D * N13, N13, kb * 64, n0, W13 + l * E_W13, D, drow, 0, scr, lane); continue; } r -= IT_13;
            { const int kb = r / 32, nb = r % 32; transpose_item(a.in[I_W2] + (size_t)l * NFF * D, D, kb * 64, nb * 32, W2 + l * E_W2, NFF, nb * 32, 0, scr, lane); }
        }
        for (int t = gw; t < 4096; t += NGW) {
            const int l = t >> 10, g = (t >> 8) & 3, cb = (t >> 4) & 15, nbk = t & 15, n = nbk * 64 + lane, c0 = cb * 8;
            const float* pw = a.in[I_POOLW] + (size_t)((l * 4 + g) * 128 + c0) * 128;
            const float* ps = a.in[I_POOLS] + l * 512 + g * 128;
            const float* wb = a.in[I_WPB] + (size_t)(l * 512 + g * 128) * D + n;
            float acc[8];
#pragma unroll
            for (int i = 0; i < 8; ++i) acc[i] = 0.f;
#pragma unroll 32
            for (int d = 0; d < 128; ++d) { const float tv = ps[d] * wb[(size_t)d * D];
#pragma unroll
                for (int i = 0; i < 8; ++i) acc[i] += pw[i * 128 + d] * tv; }
            u32x4 o; o.x = cvt_pk_bf16(acc[0], acc[1]); o.y = cvt_pk_bf16(acc[2], acc[3]); o.z = cvt_pk_bf16(acc[4], acc[5]); o.w = cvt_pk_bf16(acc[6], acc[7]);
            *(u32x4*)(WP + l * E_WP + (size_t)n * KP + 512 + g * 128 + c0) = o;
        }
        for (int idx = bid * 512 + tid; idx < 4 * 4 * 128 * 128; idx += G * 512) { const int s = idx & 127, t = (idx >> 7) & 127; const float w = a.in[I_WS][idx];
            WSM[idx] = (s <= t) ? (bf16_t)(cvt_pk_bf16(w, 0.f) & 0xffffu) : (bf16_t)0; }
    }
    if (rep_ == 0) grid.sync(); else GRID_SYNC();
}
    for (int rep_ = 0; rep_ < REP_P0; ++rep_) {
{ RELOAD_IDS();
        {
            const int wig = gw & 255, gstep = (NGW >> 8) > 0 ? (NGW >> 8) : 1;
            for (int grp = gw >> 8; grp < 8 && (gw >> 8) < gstep; grp += gstep) { const int l = grp >> 1, which = grp & 1;
                const int li = lane & 15, lq = lane >> 4;
                const float* sh = MOD + (size_t)(l * 16 + li) * NMOD + (which ? 3072 : 0) + 8 * lq;
                bf16x8 af[32];
#pragma unroll
                for (int ks = 0; ks < 32; ++ks) { const f32x4 s0 = *(const f32x4*)(sh + 32 * ks), s1 = *(const f32x4*)(sh + 32 * ks + 4);
                    u32x4 p; p.x = cvt_pk_bf16(s0[0], s0[1]); p.y = cvt_pk_bf16(s0[2], s0[3]); p.z = cvt_pk_bf16(s1[0], s1[1]); p.w = cvt_pk_bf16(s1[2], s1[3]); af[ks] = __builtin_bit_cast(bf16x8, p); }
                const bf16_t* Wt = which ? W13 + l * E_W13 : WIN + l * E_WIN; const int Nw = which ? N13 : NIN; float* SW = which ? SW2 + l * 16 * N13 : SW1 + l * 16 * NIN;
                for (int tile = wig; tile < Nw / 16; tile += 256) {
                    const bf16_t* wrow = Wt + (size_t)(tile * 16 + li) * D + 8 * lq;
                    f32x4 acc = {0.f, 0.f, 0.f, 0.f};
#pragma unroll
                    for (int kb = 0; kb < 2; ++kb) {
                        bf16x8 bfr[16];
#pragma unroll
                        for (int ks = 0; ks < 16; ++ks) bfr[ks] = *(const bf16x8*)(wrow + 32 * (16 * kb + ks));
#pragma unroll
                        for (int ks = 0; ks < 16; ++ks) acc = __builtin_amdgcn_mfma_f32_16x16x32_bf16(af[16 * kb + ks], bfr[ks], acc, 0, 0, 0);
                    }
#pragma unroll
                    for (int r = 0; r < 4; ++r) SW[(size_t)(4 * lq + r) * Nw + tile * 16 + li] = acc[r];
                }
            }
        }
        const float* x = a.in[I_X];
        for (int rowb = gw; rowb < M; rowb += 4 * NGW) {
            f32x4 v[4][4];
#pragma unroll
            for (int q = 0; q < 4; ++q) { const int row = rowb + q * NGW; const f32x4* xr = (const f32x4*)(x + (size_t)row * D) + lane;
#pragma unroll
                for (int j = 0; j < 4; ++j) v[q][j] = xr[64 * j]; }
#pragma unroll
            for (int q = 0; q < 4; ++q) {
                const int row = rowb + q * NGW, b = row >> 12; const f32x4* gr = (const f32x4*)(GM1 + b * D) + lane;
                float s = 0.f;
#pragma unroll
                for (int j = 0; j < 4; ++j) s += (v[q][j][0] * v[q][j][0] + v[q][j][1] * v[q][j][1]) + (v[q][j][2] * v[q][j][2] + v[q][j][3] * v[q][j][3]);
                s = wave_sum(s);
                if (lane == 0) *(f32x4*)(RSQ1 + (size_t)row * 4) = (f32x4){s, 0.f, 0.f, 0.f};
                u32x2* o = (u32x2*)(XG + (size_t)row * D) + lane; u32x2* ox = (u32x2*)(X16 + (size_t)row * D) + lane;
#pragma unroll
                for (int j = 0; j < 4; ++j) { const f32x4 g = v[q][j] * gr[64 * j]; u32x2 w; w.x = cvt_pk_bf16(g[0], g[1]); w.y = cvt_pk_bf16(g[2], g[3]); o[64 * j] = w;
                    u32x2 wx; wx.x = cvt_pk_bf16(v[q][j][0], v[q][j][1]); wx.y = cvt_pk_bf16(v[q][j][2], v[q][j][3]); ox[64 * j] = wx; }
            }
        }
    }
    GRID_SYNC();
}

#pragma unroll 1
    for (int l = 0; l < DEPTH; ++l) {
#pragma unroll 1
        for (int half = 0; half < 2; ++half) {
            const int row0 = half * MH;
            for (int rep_ = 0; rep_ < REP_P1; ++rep_) {
{ RELOAD_IDS();
                pg8::Gemm g{XG + (size_t)row0 * D, WIN + l * E_WIN, D, D, D};
                pg8::Order<1> S; S.init(MH, NIN, G, bid);
                EpiIn E{ZA, ZG, RSQ1, SW1 + l * 16 * NIN, row0};
                pg8::gemm_phase<EpiIn, pg8::Order<1>, true, true>(lds, g, S, E);
            }
            GRID_SYNC();
}
            for (int rep_ = 0; rep_ < REP_P2; ++rep_) {
{ RELOAD_IDS();
                for (int ch = bid; ch < MH / 128; ch += G) {
                    const int r0 = ch * 128;
                    __syncthreads();
                    {
                        const int c8 = lane * 8;
                        u32x4 wv16[16];
#pragma unroll
                        for (int i = 0; i < 16; ++i) wv16[i] = *(const u32x4*)(ZA + (size_t)(r0 + wave * 16 + i) * ZW + 512 + c8);
                        const f32x4 g0 = *(const f32x4*)(a.in[I_LNG] + l * 512 + c8), g1 = *(const f32x4*)(a.in[I_LNG] + l * 512 + c8 + 4);
                        const f32x4 b0 = *(const f32x4*)(a.in[I_LNB] + l * 512 + c8), b1 = *(const f32x4*)(a.in[I_LNB] + l * 512 + c8 + 4);
#pragma unroll
                        for (int i = 0; i < 16; ++i) {
                            const int r = wave * 16 + i;
                            const u32x4 w = wv16[i];
                            const float f0 = bflo(w.x), f1 = bfhi(w.x), f2 = bflo(w.y), f3 = bfhi(w.y), f4 = bflo(w.z), f5 = bfhi(w.z), f6 = bflo(w.w), f7 = bfhi(w.w);
                            const float mean = wave_sum(((f0 + f1) + (f2 + f3)) + ((f4 + f5) + (f6 + f7))) * (1.0f / 512.0f);
                            const float d0 = f0 - mean, d1 = f1 - mean, d2 = f2 - mean, d3 = f3 - mean, d4 = f4 - mean, d5 = f5 - mean, d6 = f6 - mean, d7 = f7 - mean;
                            const float var = wave_sum(((d0 * d0 + d1 * d1) + (d2 * d2 + d3 * d3)) + ((d4 * d4 + d5 * d5) + (d6 * d6 + d7 * d7))) * (1.0f / 512.0f);
                            const float rs = __builtin_amdgcn_rsqf(var + EPS);
                            u32x4 p; p.x = cvt_pk_bf16(d0 * rs * g0[0] + b0[0], d1 * rs * g0[1] + b0[1]); p.y = cvt_pk_bf16(d2 * rs * g0[2] + b0[2], d3 * rs * g0[3] + b0[3]);
                            p.z = cvt_pk_bf16(d4 * rs * g1[0] + b1[0], d5 * rs * g1[1] + b1[1]); p.w = cvt_pk_bf16(d6 * rs * g1[2] + b1[2], d7 * rs * g1[3] + b1[3]);
                            *(LAS u32x4*)(lds + r * 1024 + ((lane * 16) ^ (((r >> 3) & 1) << 6))) = p;
                        }
                    }
                    __syncthreads();
                    const int li = lane & 15, lq = lane >> 4;
#pragma unroll 1
                    for (int h = 0; h < 4; ++h) {
                        const int d0 = h * 128 + wave * 16;
                        const bf16_t* wsm = WSM + (size_t)((l * 4 + h) * 128) * 128;
                        const float* bs = a.in[I_BS] + (l * 4 + h) * 128;
                        u32x2 uwv[8]; float bsvv[8];
#pragma unroll
                        for (int rt = 0; rt < 8; ++rt) { const int t = 16 * rt + li; bsvv[rt] = bs[t]; uwv[rt] = *(const u32x2*)(ZA + (size_t)(r0 + t) * ZW + d0 + 4 * lq); }
                        bf16x8 vf[4];
                        const LAS bf16_t* vl = (const LAS bf16_t*)(lds + 8 * lq * 1024 + (((d0 + li) * 2) ^ ((lq & 1) << 6)));
#pragma unroll
                        for (int ks = 0; ks < 4; ++ks) {
                            unsigned e[8];
#pragma unroll
                            for (int j = 0; j < 8; ++j) e[j] = vl[(32 * ks + j) * 512];
                            u32x4 p; p.x = e[0] | (e[1] << 16); p.y = e[2] | (e[3] << 16); p.z = e[4] | (e[5] << 16); p.w = e[6] | (e[7] << 16);
                            vf[ks] = __builtin_bit_cast(bf16x8, p);
                        }
#pragma unroll
                        for (int rt = 0; rt < 8; ++rt) {
                            f32x4 acc = {0.f, 0.f, 0.f, 0.f};
                            bf16x8 wf[4];
#pragma unroll
                            for (int ks = 0; ks < 4; ++ks) if (32 * ks <= 16 * rt + 15) wf[ks] = *(const bf16x8*)(wsm + (size_t)(16 * rt + li) * 128 + 32 * ks + 8 * lq);
#pragma unroll
                            for (int ks = 0; ks < 4; ++ks) if (32 * ks <= 16 * rt + 15) acc = __builtin_amdgcn_mfma_f32_16x16x32_bf16(vf[ks], wf[ks], acc, 0, 0, 0);
                            const int t = 16 * rt + li; const float bsv = bsvv[rt];
                            const u32x2 uw = uwv[rt];
                            const float o0 = bflo(uw.x) * (acc[0] + bsv), o1 = bfhi(uw.x) * (acc[1] + bsv), o2 = bflo(uw.y) * (acc[2] + bsv), o3 = bfhi(uw.y) * (acc[3] + bsv);
                            u32x2 ow; ow.x = cvt_pk_bf16(o0, o1); ow.y = cvt_pk_bf16(o2, o3);
                            *(u32x2*)(Y + (size_t)(r0 + t) * KP + d0 + 4 * lq) = ow;
                        }
                    }
                }
                const int NT = MH / 32;
                for (int task = gw; task < 2 * NT; task += NGW) {
                    const int c8 = lane * 8;
                    if (task < NT) {
                        const int t0 = task * 32, tp0 = (row0 + t0) & (SEQ - 1), win = 2 << (lane >> 4);
                        const bf16_t* xb = ZA + 1024 + c8;
                        float S[8];
#pragma unroll
                        for (int j = 0; j < 8; ++j) S[j] = 0.f;
                        {
                            u32x4 hw[16];
#pragma unroll
                            for (int i = 1; i <= 16; ++i) { const int tt = (tp0 - i >= 0) ? t0 - i : t0; hw[i - 1] = *(const u32x4*)(xb + (size_t)tt * ZW); }
#pragma unroll
                            for (int i = 1; i <= 16; ++i) { const float mk = (i <= win && tp0 - i >= 0) ? 1.0f : 0.0f; const u32x4 w = hw[i - 1];
                                S[0] += mk * bflo(w.x); S[1] += mk * bfhi(w.x); S[2] += mk * bflo(w.y); S[3] += mk * bfhi(w.y); S[4] += mk * bflo(w.z); S[5] += mk * bfhi(w.z); S[6] += mk * bflo(w.w); S[7] += mk * bfhi(w.w); }
                        }
#pragma unroll 8
                        for (int i = 0; i < 32; ++i) {
                            const int t = t0 + i, tp = tp0 + i;
                            const u32x4 w = *(const u32x4*)(xb + (size_t)t * ZW);
                            float xv[8] = {bflo(w.x), bfhi(w.x), bflo(w.y), bfhi(w.y), bflo(w.z), bfhi(w.z), bflo(w.w), bfhi(w.w)};
#pragma unroll
                            for (int j = 0; j < 8; ++j) S[j] += xv[j];
                            if (tp - win >= 0) {
                                const u32x4 o = *(const u32x4*)(xb + (size_t)(t - win) * ZW);
                                S[0] -= bflo(o.x); S[1] -= bfhi(o.x); S[2] -= bflo(o.y); S[3] -= bfhi(o.y); S[4] -= bflo(o.z); S[5] -= bfhi(o.z); S[6] -= bflo(o.w); S[7] -= bfhi(o.w);
                            }
                            const int cnt = (tp + 1 < win) ? tp + 1 : win; const float inv = 1.0f / (float)cnt;
                            u32x4 p; p.x = cvt_pk_bf16(S[0] * inv - xv[0], S[1] * inv - xv[1]); p.y = cvt_pk_bf16(S[2] * inv - xv[2], S[3] * inv - xv[3]);
                            p.z = cvt_pk_bf16(S[4] * inv - xv[4], S[5] * inv - xv[5]); p.w = cvt_pk_bf16(S[6] * inv - xv[6], S[7] * inv - xv[7]);
                            *(u32x4*)(Y + (size_t)t * KP + 512 + c8) = p;
                        }
                    } else {
                        const int t0 = (task - NT) * 32, tp0 = (row0 + t0) & (SEQ - 1);
                        const float* cw = a.in[I_CONVW] + l * 3 * 512 + c8;
                        float w0[8], w1[8], w2[8], z1[8], z2[8];
#pragma unroll
                        for (int j = 0; j < 8; ++j) { w0[j] = cw[j]; w1[j] = cw[512 + j]; w2[j] = cw[1024 + j]; z1[j] = 0.f; z2[j] = 0.f; }
                        const bf16_t* zb = ZA + c8;
                        if (tp0 >= 1) { const u32x4 cgw = *(const u32x4*)(zb + (size_t)(t0 - 1) * ZW + 2048), hw = *(const u32x4*)(zb + (size_t)(t0 - 1) * ZW + 2560);
                            z1[0] = bflo(cgw.x) * bflo(hw.x); z1[1] = bfhi(cgw.x) * bfhi(hw.x); z1[2] = bflo(cgw.y) * bflo(hw.y); z1[3] = bfhi(cgw.y) * bfhi(hw.y);
                            z1[4] = bflo(cgw.z) * bflo(hw.z); z1[5] = bfhi(cgw.z) * bfhi(hw.z); z1[6] = bflo(cgw.w) * bflo(hw.w); z1[7] = bfhi(cgw.w) * bfhi(hw.w); }
                        if (tp0 >= 2) { const u32x4 cgw = *(const u32x4*)(zb + (size_t)(t0 - 2) * ZW + 2048), hw = *(const u32x4*)(zb + (size_t)(t0 - 2) * ZW + 2560);
                            z2[0] = bflo(cgw.x) * bflo(hw.x); z2[1] = bfhi(cgw.x) * bfhi(hw.x); z2[2] = bflo(cgw.y) * bflo(hw.y); z2[3] = bfhi(cgw.y) * bfhi(hw.y);
                            z2[4] = bflo(cgw.z) * bflo(hw.z); z2[5] = bfhi(cgw.z) * bfhi(hw.z); z2[6] = bflo(cgw.w) * bflo(hw.w); z2[7] = bfhi(cgw.w) * bfhi(hw.w); }
#pragma unroll 8
                        for (int i = 0; i < 32; ++i) {
                            const size_t ro = (size_t)(t0 + i) * ZW;
                            const u32x4 bgw = *(const u32x4*)(zb + ro + 1536), cgw = *(const u32x4*)(zb + ro + 2048), hw = *(const u32x4*)(zb + ro + 2560);
                            float z0[8] = {bflo(cgw.x) * bflo(hw.x), bfhi(cgw.x) * bfhi(hw.x), bflo(cgw.y) * bflo(hw.y), bfhi(cgw.y) * bfhi(hw.y),
                                           bflo(cgw.z) * bflo(hw.z), bfhi(cgw.z) * bfhi(hw.z), bflo(cgw.w) * bflo(hw.w), bfhi(cgw.w) * bfhi(hw.w)};
                            float bg[8] = {bflo(bgw.x), bfhi(bgw.x), bflo(bgw.y), bfhi(bgw.y), bflo(bgw.z), bfhi(bgw.z), bflo(bgw.w), bfhi(bgw.w)};
                            float o[8];
#pragma unroll
                            for (int j = 0; j < 8; ++j) { o[j] = bg[j] * (w0[j] * z2[j] + w1[j] * z1[j] + w2[j] * z0[j]); z2[j] = z1[j]; z1[j] = z0[j]; }
                            u32x4 p; p.x = cvt_pk_bf16(o[0], o[1]); p.y = cvt_pk_bf16(o[2], o[3]); p.z = cvt_pk_bf16(o[4], o[5]); p.w = cvt_pk_bf16(o[6], o[7]);
                            *(u32x4*)(Y + (size_t)(t0 + i) * KP + 1024 + c8) = p;
                        }
                    }
                }
            }
            GRID_SYNC();
}
            for (int rep_ = 0; rep_ < REP_P3; ++rep_) {
{ RELOAD_IDS();
                pg8::Gemm g{Y, WP + l * E_WP, KP, KP, 512};
                pg8::Order<3> S; S.init(MH, D, G, bid);
                EpiMerge E{ZG, MG, row0};
                pg8::gemm_phase<EpiMerge, pg8::Order<3>, true, true>(lds, g, S, E);
            }
            GRID_SYNC();
}
        }
        for (int rep_ = REP_P4 - 1; rep_ >= 0; --rep_) { RELOAD_IDS();
            pg8::Gemm g{MG, WO + l * E_WO, D, D, D};
            pg8::Order<1> S; S.init(M, D, G, bid);
            EpiRes E{X16, (void*)X16, true, MOD + l * 16 * NMOD + 2048, GM2 + l * 16 * D, RSQ2, XG, (LAS float*)(lds + 131072 + 1024)};
            pg8::gemm_phase<EpiRes, pg8::Order<1>, true, true>(lds, g, S, E);
        GRID_SYNC();
        }
        for (int rep_ = 0; rep_ < REP_P5; ++rep_) {
{ RELOAD_IDS();
            pg8::Gemm g{XG, W13 + l * E_W13, D, D, D};
            pg8::Order<1> S; S.init(M, N13, G, bid);
            EpiFfn E{Hb, RSQ2, SW2 + l * 16 * N13};
            pg8::gemm_phase<EpiFfn, pg8::Order<1>, true, true>(lds, g, S, E);
        }
        GRID_SYNC();
}
        for (int rep_ = REP_P6 - 1; rep_ >= 0; --rep_) { RELOAD_IDS();
            pg8::Gemm g{Hb, W2 + l * E_W2, NFF, NFF, NFF};
            pg8::Order<1> S; S.init(M, D, G, bid);
            EpiRes E{X16, (l + 1 < DEPTH) ? (void*)X16 : (void*)XF, l + 1 < DEPTH, MOD + l * 16 * NMOD + 5120, (l + 1 < DEPTH) ? GM1 + (l + 1) * 16 * D : nullptr, RSQ1, XG, (LAS float*)(lds + 131072 + 1024)};
            pg8::gemm_phase<EpiRes, pg8::Order<1>, true, true>(lds, g, S, E);
        GRID_SYNC();
        }
    }
    { RELOAD_IDS();
        const f32x4* gf = (const f32x4*)a.in[I_GFINAL] + lane;
        for (int rowb = gw; rowb < M; rowb += 4 * NGW) {
            f32x4 v[4][4], pq[4];
#pragma unroll
            for (int q = 0; q < 4; ++q) { const int row = rowb + q * NGW; const f32x4* xr = (const f32x4*)(XF + (size_t)row * D) + lane; pq[q] = *(const f32x4*)(RSQ1 + (size_t)row * 4);
#pragma unroll
                for (int j = 0; j < 4; ++j) v[q][j] = xr[64 * j]; }
#pragma unroll
            for (int q = 0; q < 4; ++q) { const int row = rowb + q * NGW;
                const float rs = __builtin_amdgcn_rsqf(((pq[q][0] + pq[q][1]) + (pq[q][2] + pq[q][3])) * (1.0f / D) + EPS);
                f32x4* orow = (f32x4*)(a.out + (size_t)row * D) + lane;
#pragma unroll
                for (int j = 0; j < 4; ++j) orow[64 * j] = v[q][j] * rs * gf[64 * j]; }
        }
    }
}

extern "C" void kernel_launch(void* const* d_in, const int* in_sizes, int n_in, void* d_out, int out_size, void* d_ws, size_t ws_size, hipStream_t stream) {
    static int grid = 0;
    if (grid == 0) {
        if (n_in != 21 || in_sizes[0] != M * D || out_size != M * D || ws_size < WS_BAR + BAR_BYTES) { fprintf(stderr, "kernel_launch: unexpected shapes / workspace (n_in %d, ws %zu)\n", n_in, ws_size); grid = -1; return; }
        int dev = 0, cus = 0, per_cu = 0;
        (void)hipGetDevice(&dev);
        (void)hipDeviceGetAttribute(&cus, hipDeviceAttributeMultiprocessorCount, dev);
        if (hipFuncSetAttribute((const void*)fwd_megakernel, hipFuncAttributeMaxDynamicSharedMemorySize, LDS_BYTES) != hipSuccess) { fprintf(stderr, "kernel_launch: hipFuncSetAttribute failed\n"); grid = -1; return; }
        if (hipOccupancyMaxActiveBlocksPerMultiprocessor(&per_cu, (const void*)fwd_megakernel, 512, LDS_BYTES) != hipSuccess || per_cu < 1) { fprintf(stderr, "kernel_launch: occupancy query gave %d\n", per_cu); per_cu = 1; }
        (void)hipGetLastError();
        grid = cus * 1;
        if (grid > 256) grid = 256;
    }
    if (grid < 0) return;
    if (hipMemsetAsync((char*)d_ws + WS_BAR, 0, BAR_BYTES, stream) != hipSuccess) { fprintf(stderr, "kernel_launch: memset failed\n"); return; }
    Args a{};
    for (int i = 0; i < 21; ++i) a.in[i] = (const float*)d_in[i];
    a.out = (float*)d_out; a.ws = (unsigned char*)d_ws;
    void* args[] = {&a};
    hipError_t e = hipLaunchCooperativeKernel((const void*)fwd_megakernel, dim3(grid), dim3(512), args, LDS_BYTES, stream);
    if (e != hipSuccess) fprintf(stderr, "kernel_launch: cooperative launch failed: %s (grid %d)\n", hipGetErrorString(e), grid);
}
```

```cpp
#include <hip/hip_runtime.h>
#include <hip/hip_cooperative_groups.h>
#include <cstdio>
#include <cstdint>
namespace cg = cooperative_groups;

#define LAS __attribute__((address_space(3)))
typedef unsigned short bf16_t;
typedef short bf16x8 __attribute__((ext_vector_type(8)));
typedef float f32x4 __attribute__((ext_vector_type(4)));
typedef float f32x2 __attribute__((ext_vector_type(2)));
typedef unsigned u32x4 __attribute__((ext_vector_type(4)));
typedef unsigned u32x2 __attribute__((ext_vector_type(2)));

constexpr int D = 1024, BATCH = 16, SEQ = 4096, DEPTH = 4, M = BATCH * SEQ, MH = M / 2;
constexpr int NIN = 6144, NFF = 2816, N13 = 5632, KP = 1536, NMOD = 6144, ZW = 3072;
constexpr float EPS = 1e-6f;
constexpr size_t MiB = 1u << 20;
constexpr size_t WS_ZA = 0, WS_ZG = 192 * MiB, WS_Y = 384 * MiB, WS_MG = 480 * MiB, WS_XG = 608 * MiB, WS_H = 0;
constexpr size_t WS_W = 736 * MiB;
constexpr size_t E_WIN = (size_t)NIN * D, E_WP = (size_t)D * KP, E_WO = (size_t)D * D, E_W13 = (size_t)N13 * D, E_W2 = (size_t)D * NFF;
constexpr size_t WS_WIN = WS_W, WS_WP = WS_WIN + 4 * E_WIN * 2, WS_WO = WS_WP + 4 * E_WP * 2, WS_W13 = WS_WO + 4 * E_WO * 2, WS_W2 = WS_W13 + 4 * E_W13 * 2, WS_WEND = WS_W2 + 4 * E_W2 * 2;
constexpr size_t WS_SM = 872 * MiB;
constexpr size_t WS_MOD = WS_SM, WS_GM1 = WS_MOD + (size_t)4 * 16 * NMOD * 4, WS_GM2 = WS_GM1 + (size_t)4 * 16 * D * 4, WS_SW1 = WS_GM2 + (size_t)4 * 16 * D * 4,
                 WS_SW2 = WS_SW1 + (size_t)4 * 16 * NIN * 4, WS_RSQ1 = WS_SW2 + (size_t)4 * 16 * N13 * 4, WS_RSQ2 = WS_RSQ1 + (size_t)M * 16, WS_WSM = WS_RSQ2 + (size_t)M * 16,
                 WS_END = WS_WSM + (size_t)4 * 4 * 128 * 128 * 2;
constexpr size_t WS_BAR = (WS_END + 4095) / 4096 * 4096, BAR_BYTES = 16384;
constexpr size_t WS_XF = 352 * MiB;
static_assert(WS_XF + (size_t)M * D * 4 <= WS_XG && WS_H + (size_t)M * NFF * 2 <= WS_XF, "ws map 2");
static_assert(WS_WEND <= WS_SM && WS_BAR + BAR_BYTES <= 1024 * MiB, "ws map");
static_assert(WS_H + (size_t)M * NFF * 2 <= WS_XG, "H overlay");

constexpr int LDS_BYTES = 131072 + 8192;
#ifndef REP_P0
#define REP_P0 1
#endif
#ifndef REP_P1
#define REP_P1 1
#endif
#ifndef REP_P2
#define REP_P2 1
#endif
#ifndef REP_P3
#define REP_P3 1
#endif
#ifndef REP_P4
#define REP_P4 1
#endif
#ifndef REP_P6
#define REP_P6 1
#endif
#ifndef REP_P5
#define REP_P5 1
#endif


__device__ __forceinline__ float bflo(unsigned w) { return __uint_as_float(w << 16); }
__device__ __forceinline__ float bfhi(unsigned w) { return __uint_as_float(w & 0xffff0000u); }
__device__ __forceinline__ float bf2f(bf16_t h) { return __uint_as_float(((unsigned)h) << 16); }
__device__ __forceinline__ unsigned cvt_pk_bf16(float lo, float hi) { unsigned r; asm volatile("v_cvt_pk_bf16_f32 %0, %1, %2" : "=v"(r) : "v"(lo), "v"(hi)); return r; }
__device__ __forceinline__ float fsigmoid(float x) { return __builtin_amdgcn_rcpf(1.0f + __expf(-x)); }
__device__ __forceinline__ float fsilu(float x) { return x * fsigmoid(x); }
__device__ __forceinline__ float fgelu(float x) { const float y = 1.5957691216057308f * (x + 0.044715f * x * x * x); return x * fsigmoid(y); }
constexpr float LOG2E = 1.4426950408889634f;
__device__ __forceinline__ float sig_from_e(float e) { return __builtin_amdgcn_rcpf(1.0f + e); }
__device__ __forceinline__ float wave_sum(float v) {
#pragma unroll
    for (int o = 1; o < 64; o <<= 1) v += __shfl_xor(v, o);
    return v;
}

namespace pg8 {
constexpr int BM = 256, BK = 64, HALF = 128, HTB = HALF * BK * 2, STAGE_BYTES = 8 * HTB, NXCD = 8, WGM = 4;
__host__ __device__ __forceinline__ int lds_byte(int r, int c) { const int st = (r >> 4) * 2 + (c >> 5), rr = r & 15, cc = c & 31, ob = rr * 64 + cc * 2; return st * 1024 + (ob ^ (((ob >> 9) & 1) << 5)); }
__host__ __device__ __forceinline__ void stage_rc(int b, int& R, int& C) { const int st = b / 1024, sb = b % 1024, swz = sb ^ (((sb >> 9) & 1) << 5); R = (st >> 1) * 16 + swz / 64; C = (st & 1) * 32 + (swz % 64) / 2; }
__host__ __device__ __forceinline__ int perm32(int rho) { const int n = rho >> 4, i = rho & 15; return 8 * (i >> 2) + 4 * n + (i & 3); }

struct Unit { int pm, pn, seg; };
struct Gemm { const bf16_t* A; const bf16_t* Bt; int lda, ldb, K; };

template <int NSEG> struct Order {
    int nM, nN, nwg, G, c;
    __device__ void init(int Mrows, int Ncols, int G_, int c_) { nM = Mrows / BM; nN = Ncols / BM; nwg = nM * nN; G = G_; c = c_; }
    __device__ bool next(int i, Unit& u) const {
        const int ti = i / NSEG; u.seg = i - ti * NSEG;
        const long L = (long)ti * G + c; if (L >= nwg) return false;
        int wgid = (int)L; { const int q = nwg / NXCD, r = nwg % NXCD, xcd = wgid % NXCD, off = wgid / NXCD; wgid = (xcd < r ? xcd * (q + 1) : r * (q + 1) + (xcd - r) * q) + off; }
        const int nig = WGM * nN, gid = wgid / nig, fm = gid * WGM, gsz = (nM - fm) < WGM ? (nM - fm) : WGM;
        u.pm = fm + ((wgid % nig) % gsz); u.pn = (wgid % nig) / gsz; return true;
    }
};

template <class Epi, class Sched, bool ALIGN_EPI, bool SP2>
__device__ __forceinline__ void gemm_phase(LAS unsigned char* lds, const Gemm g, const Sched& S, const Epi& E) {
    int tid = threadIdx.x; asm volatile("" : "+v"(tid));
    const int wid = __builtin_amdgcn_readfirstlane(tid >> 6), lane = tid & 63, wr = wid >> 2, wc = wid & 3, fr = lane & 15, fq = lane >> 4;
    const int K = g.K, nt = K / BK;
    unsigned voffA[2], voffB[2];
#pragma unroll
    for (int i = 0; i < 2; ++i) { int R, C; stage_rc(tid * 16 + i * 8192, R, C); const int Rb = Epi::PERM ? ((R & ~31) + perm32(R & 31)) : R;
        voffA[i] = (unsigned)(R * g.lda + C) * 2u; voffB[i] = (unsigned)(Rb * g.ldb + C) * 2u; }
    const size_t kstep = (size_t)(BK * 2);
    const size_t hstepA = (size_t)HALF * g.lda * 2, hstepB = (size_t)HALF * g.ldb * 2;
    const size_t segb = (size_t)K * 2;
    const unsigned ldsw = (unsigned)wid * 1024u;
    const int aoff = lds_byte(wr * 64 + fr, fq * 8), boff = lds_byte(wc * 32 + fr, fq * 8);
#define PG8_SA(b, h) (((b) * 2 + (h)) * HTB)
#define PG8_SB(b, h) ((4 + (b) * 2 + (h)) * HTB)
#define PG8_STAGE(bufoff, gbase, voff) do { _Pragma("unroll") for (int _i = 0; _i < 2; ++_i) \
        __builtin_amdgcn_global_load_lds((const unsigned*)((const char*)(gbase) + (voff)[_i]), (LAS unsigned*)(lds + (bufoff) + ldsw + _i * 8192), 16, 0, 0); } while (0)
#define PG8_LDA(dst, b, h) do { _Pragma("unroll") for (int m = 0; m < 4; ++m) _Pragma("unroll") for (int k = 0; k < 2; ++k) dst[m][k] = *(const LAS bf16x8*)(lds + PG8_SA(b, h) + aoff + m * 2048 + k * 1024); } while (0)
#define PG8_LDB(dst, b, h) do { _Pragma("unroll") for (int n = 0; n < 2; ++n) _Pragma("unroll") for (int k = 0; k < 2; ++k) dst[n][k] = *(const LAS bf16x8*)(lds + PG8_SB(b, h) + boff + n * 2048 + k * 1024); } while (0)
#define PG8_MMA(ai, bj, At, Bt) do { __builtin_amdgcn_s_setprio(1); _Pragma("unroll") for (int m = 0; m < 4; ++m) _Pragma("unroll") for (int n = 0; n < 2; ++n) _Pragma("unroll") for (int k = 0; k < 2; ++k) \
        acc[ai][bj][m][n] = __builtin_amdgcn_mfma_f32_16x16x32_bf16(Bt[n][k], At[m][k], acc[ai][bj][m][n], 0, 0, 0); __builtin_amdgcn_s_setprio(0); } while (0)
#define PG8_WAIT_V(n) asm volatile("s_waitcnt vmcnt(" #n ")" ::: "memory")
#define PG8_WAIT_L(n) asm volatile("s_waitcnt lgkmcnt(" #n ")" ::: "memory")
#define PG8_BAR __builtin_amdgcn_s_barrier()
#define PG8_SCHED __builtin_amdgcn_sched_barrier(0)
    Unit cur, nxt; int ui = 0;
    if (!S.next(0, cur)) return;
    f32x4 acc[2][2][4][2];
#pragma unroll
    for (int a = 0; a < 2; ++a)
#pragma unroll
        for (int b = 0; b < 2; ++b)
#pragma unroll
            for (int m = 0; m < 4; ++m)
#pragma unroll
                for (int n = 0; n < 2; ++n) acc[a][b][m][n] = (f32x4){0.f, 0.f, 0.f, 0.f};
    bf16x8 At[4][2], B0[2][2], B1[2][2];
    const char* cA = (const char*)g.A + (size_t)cur.pm * 2 * hstepA + (size_t)cur.seg * segb; const char* cB = (const char*)g.Bt + (size_t)cur.pn * 2 * hstepB + (size_t)cur.seg * segb;
    if constexpr (SP2) {
        PG8_STAGE(PG8_SB(0, 0), cB, voffB); PG8_STAGE(PG8_SB(0, 1), cB + hstepB, voffB); PG8_STAGE(PG8_SA(0, 0), cA, voffA); PG8_STAGE(PG8_SA(0, 1), cA + hstepA, voffA);
        if (wr == 1) PG8_BAR;
        PG8_WAIT_V(2); PG8_BAR;
        PG8_STAGE(PG8_SB(1, 0), cB + kstep, voffB); PG8_STAGE(PG8_SA(1, 0), cA + kstep, voffA); PG8_STAGE(PG8_SB(1, 1), cB + hstepB + kstep, voffB);
        PG8_WAIT_V(6); PG8_BAR;
    } else {
        PG8_STAGE(PG8_SB(0, 0), cB, voffB); PG8_STAGE(PG8_SA(0, 0), cA, voffA); PG8_STAGE(PG8_SB(0, 1), cB + hstepB, voffB); PG8_STAGE(PG8_SA(0, 1), cA + hstepA, voffA);
        if (wr == 1) PG8_BAR;
        PG8_WAIT_V(4); PG8_BAR;
        PG8_STAGE(PG8_SB(1, 0), cB + kstep, voffB); PG8_STAGE(PG8_SA(1, 0), cA + kstep, voffA); PG8_STAGE(PG8_SB(1, 1), cB + hstepB + kstep, voffB);
        PG8_WAIT_V(6); PG8_BAR;
    }
    for (;;) {
        const bool has_next = S.next(ui + 1, nxt);
        const char* nA = has_next ? (const char*)g.A + (size_t)nxt.pm * 2 * hstepA + (size_t)nxt.seg * segb : cA;
        const char* nB = has_next ? (const char*)g.Bt + (size_t)nxt.pn * 2 * hstepB + (size_t)nxt.seg * segb : cB;
        for (int t = 0; t < nt; t += 2) {
            const bool last = (t == nt - 2);
            const char* a1 = cA + (size_t)(t + 1) * kstep;
            const char* a2 = last ? nA : cA + (size_t)(t + 2) * kstep; const char* b2 = last ? nB : cB + (size_t)(t + 2) * kstep;
            const char* a3 = a2 + kstep; const char* b3 = b2 + kstep;
            if constexpr (SP2) {
            PG8_LDB(B0, 0, 0); PG8_LDB(B1, 0, 1); PG8_SCHED; PG8_LDA(At, 0, 0); PG8_STAGE(PG8_SA(1, 1), a1 + hstepA, voffA);
            PG8_WAIT_V(8); PG8_WAIT_L(0); PG8_BAR; PG8_MMA(0, 0, At, B0); PG8_MMA(0, 1, At, B1); PG8_BAR; PG8_SCHED;
            PG8_LDA(At, 0, 1); PG8_STAGE(PG8_SB(0, 0), b2, voffB); PG8_STAGE(PG8_SB(0, 1), b2 + hstepB, voffB); PG8_STAGE(PG8_SA(0, 0), a2, voffA);
            PG8_WAIT_V(8); PG8_WAIT_L(0); PG8_BAR; PG8_MMA(1, 0, At, B0); PG8_MMA(1, 1, At, B1); PG8_BAR; PG8_SCHED;
            PG8_LDB(B0, 1, 0); PG8_LDB(B1, 1, 1); PG8_SCHED; PG8_LDA(At, 1, 0); PG8_STAGE(PG8_SA(0, 1), a2 + hstepA, voffA);
            PG8_WAIT_V(8); PG8_WAIT_L(0); PG8_BAR; PG8_MMA(0, 0, At, B0); PG8_MMA(0, 1, At, B1); PG8_BAR; PG8_SCHED;
            PG8_LDA(At, 1, 1); PG8_STAGE(PG8_SB(1, 0), b3, voffB); PG8_STAGE(PG8_SB(1, 1), b3 + hstepB, voffB); PG8_STAGE(PG8_SA(1, 0), a3, voffA);
            PG8_WAIT_V(8); PG8_WAIT_L(0); PG8_BAR; PG8_MMA(1, 0, At, B0); PG8_MMA(1, 1, At, B1); PG8_BAR; PG8_SCHED;
            } else {
            PG8_LDB(B0, 0, 0); PG8_SCHED; PG8_LDA(At, 0, 0); PG8_STAGE(PG8_SA(1, 1), a1 + hstepA, voffA);
            PG8_WAIT_L(8); PG8_BAR; PG8_WAIT_L(0); PG8_MMA(0, 0, At, B0); PG8_BAR; PG8_SCHED;
            PG8_LDB(B1, 0, 1); PG8_STAGE(PG8_SB(0, 0), b2, voffB);
            PG8_BAR; PG8_WAIT_L(0); PG8_MMA(0, 1, At, B1); PG8_BAR;
            PG8_LDA(At, 0, 1); PG8_STAGE(PG8_SA(0, 0), a2, voffA);
            PG8_BAR; PG8_WAIT_L(0); PG8_MMA(1, 0, At, B0); PG8_BAR; PG8_SCHED;
            PG8_STAGE(PG8_SB(0, 1), b2 + hstepB, voffB);
            PG8_WAIT_V(6); PG8_BAR; PG8_MMA(1, 1, At, B1); PG8_BAR;
            PG8_LDB(B0, 1, 0); PG8_SCHED; PG8_LDA(At, 1, 0); PG8_STAGE(PG8_SA(0, 1), a2 + hstepA, voffA);
            PG8_WAIT_L(8); PG8_BAR; PG8_WAIT_L(0); PG8_MMA(0, 0, At, B0); PG8_BAR; PG8_SCHED;
            PG8_LDB(B1, 1, 1); PG8_STAGE(PG8_SB(1, 0), b3, voffB);
            PG8_BAR; PG8_WAIT_L(0); PG8_MMA(0, 1, At, B1); PG8_BAR;
            PG8_LDA(At, 1, 1); PG8_STAGE(PG8_SA(1, 0), a3, voffA);
            PG8_BAR; PG8_WAIT_L(0); PG8_MMA(1, 0, At, B0); PG8_BAR; PG8_SCHED;
            PG8_STAGE(PG8_SB(1, 1), b3 + hstepB, voffB);
            PG8_WAIT_V(6); PG8_BAR; PG8_MMA(1, 1, At, B1); PG8_BAR;
            }
        }
        if constexpr (ALIGN_EPI) { if (wr == 0) PG8_BAR; }
        E(acc, cur, wr, wc, fr, fq);
        if (!has_next) break;
        if (!Epi::ACCUM || nxt.seg == 0) {
#pragma unroll
            for (int a = 0; a < 2; ++a)
#pragma unroll
                for (int b = 0; b < 2; ++b)
#pragma unroll
                    for (int m = 0; m < 4; ++m)
#pragma unroll
                        for (int n = 0; n < 2; ++n) acc[a][b][m][n] = (f32x4){0.f, 0.f, 0.f, 0.f};
        }
        cur = nxt; cA = nA; cB = nB; ++ui;
        if constexpr (ALIGN_EPI) { if (wr == 1) PG8_BAR; }
    }
    PG8_WAIT_V(0);
    if constexpr (!ALIGN_EPI) { if (wr == 0) PG8_BAR; }
    PG8_BAR;
#undef PG8_SA
#undef PG8_SB
#undef PG8_STAGE
#undef PG8_LDA
#undef PG8_LDB
#undef PG8_MMA
#undef PG8_WAIT_V
#undef PG8_WAIT_L
#undef PG8_BAR
#undef PG8_SCHED
}
}
using pg8::Unit;

struct EpiIn {
    static constexpr bool PERM = true, ACCUM = false;
    bf16_t* ZA; bf16_t* ZG; const float* rowsq; const float* sW; int row0;
    __device__ __forceinline__ void operator()(f32x4 (&acc)[2][2][4][2], const Unit& u, int wr, int wc, int fr, int fq) const {
        const int lrow0 = u.pm * 256 + wr * 64 + fr, b = (row0 + u.pm * 256) >> 12, colin = u.pn * 256 + wc * 32 + 8 * fq;
        const float* swp = sW + b * NIN + colin;
        f32x4 sw[2][2];
#pragma unroll
        for (int bj = 0; bj < 2; ++bj)
#pragma unroll
            for (int n = 0; n < 2; ++n) sw[bj][n] = *(const f32x4*)(swp + 128 * bj + 4 * n);
        bf16_t* outp; int colo, mode;
        if (u.pn < 12) { outp = ZA; colo = colin; mode = (u.pn < 4) ? 1 : (u.pn >= 8 ? 3 : 0); } else { outp = ZG; colo = colin - ZW; mode = 2;
#pragma unroll
            for (int bj = 0; bj < 2; ++bj)
#pragma unroll
                for (int n = 0; n < 2; ++n) sw[bj][n] *= -LOG2E; }
        float rq[2][4];
#pragma unroll
        for (int ai = 0; ai < 2; ++ai)
#pragma unroll
            for (int m = 0; m < 4; ++m) { const f32x4 p = *(const f32x4*)(rowsq + (size_t)(row0 + lrow0 + ai * 128 + m * 16) * 4); rq[ai][m] = (p[0] + p[1]) + (p[2] + p[3]); }
#pragma unroll
        for (int ai = 0; ai < 2; ++ai)
#pragma unroll
            for (int m = 0; m < 4; ++m) {
                const int lr = lrow0 + ai * 128 + m * 16;
                float rs = __builtin_amdgcn_rsqf(rq[ai][m] * (1.0f / D) + EPS);
                if (mode == 2) rs *= -LOG2E;
                bf16_t* rowp = outp + (size_t)lr * ZW + colo;
                if (mode == 3) {
                    const f32x4 p0 = (acc[ai][0][m][0] * rs + sw[0][0]) * (acc[ai][1][m][0] * rs + sw[1][0]), p1 = (acc[ai][0][m][1] * rs + sw[0][1]) * (acc[ai][1][m][1] * rs + sw[1][1]);
                    u32x4 w; w.x = cvt_pk_bf16(p0[0], p0[1]); w.y = cvt_pk_bf16(p0[2], p0[3]); w.z = cvt_pk_bf16(p1[0], p1[1]); w.w = cvt_pk_bf16(p1[2], p1[3]);
                    *(u32x4*)(ZA + (size_t)lr * ZW + 2048 + (u.pn - 8) * 128 + wc * 32 + 8 * fq) = w;
                    continue;
                }
#pragma unroll
                for (int bj = 0; bj < 2; ++bj) {
                    f32x4 v0 = acc[ai][bj][m][0] * rs + sw[bj][0], v1 = acc[ai][bj][m][1] * rs + sw[bj][1];
                    if (mode == 1) {
                        const float c1 = -1.5957691216057308f * LOG2E, c3 = c1 * 0.044715f;
                        const f32x4 p0 = (v0 * v0) * c3 + c1, p1 = (v1 * v1) * c3 + c1;
                        const f32x4 q0 = v0 * p0, q1 = v1 * p1;
#pragma unroll
                        for (int j = 0; j < 4; ++j) { v0[j] *= sig_from_e(__builtin_amdgcn_exp2f(q0[j])); v1[j] *= sig_from_e(__builtin_amdgcn_exp2f(q1[j])); }
                    } else if (mode == 2) {
#pragma unroll
                        for (int j = 0; j < 4; ++j) { v0[j] = sig_from_e(__builtin_amdgcn_exp2f(v0[j])); v1[j] = sig_from_e(__builtin_amdgcn_exp2f(v1[j])); }
                    }
                    u32x4 w; w.x = cvt_pk_bf16(v0[0], v0[1]); w.y = cvt_pk_bf16(v0[2], v0[3]); w.z = cvt_pk_bf16(v1[0], v1[1]); w.w = cvt_pk_bf16(v1[2], v1[3]);
                    *(u32x4*)(rowp + 128 * bj) = w;
                }
            }
    }
};

struct EpiMerge {
    static constexpr bool PERM = true, ACCUM = true;
    const bf16_t* ZG; bf16_t* MG; int row0;
    __device__ __forceinline__ void operator()(f32x4 (&acc)[2][2][4][2], const Unit& u, int wr, int wc, int fr, int fq) const {
        const int lrow0 = u.pm * 256 + wr * 64 + fr, col = u.pn * 256 + wc * 32 + 8 * fq;
        const float tiny = 1e-30f;
        const bf16_t* gp = ZG + (size_t)lrow0 * ZW + col + u.seg * 1024;
        if (u.seg < 2) {
            u32x4 gd[2][4][2], gn[4][2];
#pragma unroll
            for (int ai = 0; ai < 2; ++ai)
#pragma unroll
                for (int m = 0; m < 4; ++m)
#pragma unroll
                    for (int bj = 0; bj < 2; ++bj) gd[ai][m][bj] = *(const u32x4*)(gp + (size_t)(ai * 128 + m * 16) * ZW + 1024 + 128 * bj);
#pragma unroll
            for (int ai = 0; ai < 2; ++ai) {
#pragma unroll
                for (int m = 0; m < 4; ++m)
#pragma unroll
                    for (int bj = 0; bj < 2; ++bj) {
                        const u32x4 ga = gd[ai][m][bj];
                        f32x4 a0 = {bflo(ga.x), bfhi(ga.x), bflo(ga.y), bfhi(ga.y)}, a1 = {bflo(ga.z), bfhi(ga.z), bflo(ga.w), bfhi(ga.w)};
#pragma unroll
                        for (int j = 0; j < 4; ++j) { a0[j] = __builtin_amdgcn_rcpf(fmaxf(a0[j], tiny)); a1[j] = __builtin_amdgcn_rcpf(fmaxf(a1[j], tiny)); }
                        acc[ai][bj][m][0] *= a0; acc[ai][bj][m][1] *= a1;
                    }
                asm volatile("" ::: "memory");
                if (ai == 1) {
#pragma unroll
                    for (int m = 0; m < 4; ++m)
#pragma unroll
                        for (int bj = 0; bj < 2; ++bj) {
                            const u32x4 ga = gn[m][bj];
                            f32x4 a0 = {bflo(ga.x), bfhi(ga.x), bflo(ga.y), bfhi(ga.y)}, a1 = {bflo(ga.z), bfhi(ga.z), bflo(ga.w), bfhi(ga.w)};
#pragma unroll
                            for (int j = 0; j < 4; ++j) { a0[j] = fmaxf(a0[j], tiny); a1[j] = fmaxf(a1[j], tiny); }
                            acc[0][bj][m][0] *= a0; acc[0][bj][m][1] *= a1;
                        }
                }
#pragma unroll
                for (int m = 0; m < 4; ++m)
#pragma unroll
                    for (int bj = 0; bj < 2; ++bj) gn[m][bj] = *(const u32x4*)(gp + (size_t)(ai * 128 + m * 16) * ZW + 128 * bj);
                asm volatile("" ::: "memory");
            }
#pragma unroll
            for (int m = 0; m < 4; ++m)
#pragma unroll
                for (int bj = 0; bj < 2; ++bj) {
                    const u32x4 ga = gn[m][bj];
                    f32x4 a0 = {bflo(ga.x), bfhi(ga.x), bflo(ga.y), bfhi(ga.y)}, a1 = {bflo(ga.z), bfhi(ga.z), bflo(ga.w), bfhi(ga.w)};
#pragma unroll
                    for (int j = 0; j < 4; ++j) { a0[j] = fmaxf(a0[j], tiny); a1[j] = fmaxf(a1[j], tiny); }
                    acc[1][bj][m][0] *= a0; acc[1][bj][m][1] *= a1;
                }
        } else {
            u32x4 gv[2][4][2];
#pragma unroll
            for (int ai = 0; ai < 2; ++ai)
#pragma unroll
                for (int m = 0; m < 4; ++m)
#pragma unroll
                    for (int bj = 0; bj < 2; ++bj) gv[ai][m][bj] = *(const u32x4*)(gp + (size_t)(ai * 128 + m * 16) * ZW + 128 * bj);
#pragma unroll
            for (int ai = 0; ai < 2; ++ai)
#pragma unroll
                for (int m = 0; m < 4; ++m)
#pragma unroll
                    for (int bj = 0; bj < 2; ++bj) {
                        const u32x4 ga = gv[ai][m][bj];
                        f32x4 a0 = {bflo(ga.x), bfhi(ga.x), bflo(ga.y), bfhi(ga.y)}, a1 = {bflo(ga.z), bfhi(ga.z), bflo(ga.w), bfhi(ga.w)};
#pragma unroll
                        for (int j = 0; j < 4; ++j) { a0[j] = fmaxf(a0[j], tiny); a1[j] = fmaxf(a1[j], tiny); }
                        const f32x4 v0 = acc[ai][bj][m][0] * a0, v1 = acc[ai][bj][m][1] * a1;
                        u32x4 w; w.x = cvt_pk_bf16(v0[0], v0[1]); w.y = cvt_pk_bf16(v0[2], v0[3]); w.z = cvt_pk_bf16(v1[0], v1[1]); w.w = cvt_pk_bf16(v1[2], v1[3]);
                        *(u32x4*)(MG + (size_t)(row0 + lrow0 + ai * 128 + m * 16) * D + col + 128 * bj) = w;
                    }
        }
    }
};

struct EpiRes {
    static constexpr bool PERM = true, ACCUM = false;
    const bf16_t* xin; void* xout; bool out_bf; const float* gate; const float* gmn; float* rowsq; bf16_t* XG; LAS float* red;
    __device__ __forceinline__ void operator()(f32x4 (&acc)[2][2][4][2], const Unit& u, int wr, int wc, int fr, int fq) const {
        const int row0 = u.pm * 256 + wr * 64 + fr, b = u.pm >> 4, col0 = u.pn * 256 + wc * 32 + 8 * fq;
        float ss[2][4];
#pragma unroll
        for (int ai = 0; ai < 2; ++ai)
#pragma unroll
            for (int m = 0; m < 4; ++m) ss[ai][m] = 0.f;
#pragma unroll
        for (int bj = 0; bj < 2; ++bj) {
            const int col = col0 + 128 * bj;
            f32x4 gt[2], gm[2];
#pragma unroll
            for (int n = 0; n < 2; ++n) { gt[n] = *(const f32x4*)(gate + b * NMOD + col + 4 * n);
                gm[n] = (f32x4){0.f, 0.f, 0.f, 0.f}; if (gmn) gm[n] = *(const f32x4*)(gmn + b * D + col + 4 * n); }
#pragma unroll
            for (int ai = 0; ai < 2; ++ai) {
                u32x4 xb[4];
#pragma unroll
                for (int m = 0; m < 4; ++m) { const unsigned vo = (unsigned)((row0 + ai * 128 + m * 16) * D + col) * 2u;
                    asm volatile("global_load_dwordx4 %0, %1, %2" : "=&v"(xb[m]) : "v"(vo), "s"(xin) : "memory"); }
                asm volatile("s_waitcnt vmcnt(0)" : "+v"(xb[0]), "+v"(xb[1]), "+v"(xb[2]), "+v"(xb[3]) :: "memory");
#pragma unroll
                for (int m = 0; m < 4; ++m) {
                    const size_t off = (size_t)(row0 + ai * 128 + m * 16) * D + col;
                    const u32x4 w = xb[m];
                    f32x4 x0 = (f32x4){bflo(w.x), bfhi(w.x), bflo(w.y), bfhi(w.y)} + gt[0] * acc[ai][bj][m][0];
                    f32x4 x1 = (f32x4){bflo(w.z), bfhi(w.z), bflo(w.w), bfhi(w.w)} + gt[1] * acc[ai][bj][m][1];
                    if (out_bf) { u32x4 o; o.x = cvt_pk_bf16(x0[0], x0[1]); o.y = cvt_pk_bf16(x0[2], x0[3]); o.z = cvt_pk_bf16(x1[0], x1[1]); o.w = cvt_pk_bf16(x1[2], x1[3]);
                        *(u32x4*)((bf16_t*)xout + off) = o;
                        x0 = (f32x4){bflo(o.x), bfhi(o.x), bflo(o.y), bfhi(o.y)}; x1 = (f32x4){bflo(o.z), bfhi(o.z), bflo(o.w), bfhi(o.w)}; }
                    else { *(f32x4*)((float*)xout + off) = x0; *(f32x4*)((float*)xout + off + 4) = x1; }
                    ss[ai][m] += ((x0[0] * x0[0] + x0[1] * x0[1]) + (x0[2] * x0[2] + x0[3] * x0[3])) + ((x1[0] * x1[0] + x1[1] * x1[1]) + (x1[2] * x1[2] + x1[3] * x1[3]));
                    if (gmn) { const f32x4 g0 = x0 * gm[0], g1 = x1 * gm[1]; u32x4 o; o.x = cvt_pk_bf16(g0[0], g0[1]); o.y = cvt_pk_bf16(g0[2], g0[3]); o.z = cvt_pk_bf16(g1[0], g1[1]); o.w = cvt_pk_bf16(g1[2], g1[3]);
                        *(u32x4*)(XG + off) = o; }
                }
                asm volatile("" ::: "memory");
            }
            asm volatile("" ::: "memory");
        }
#pragma unroll
        for (int ai = 0; ai < 2; ++ai)
#pragma unroll
            for (int m = 0; m < 4; ++m) {
                float s = ss[ai][m]; s += __shfl_xor(s, 16); s += __shfl_xor(s, 32);
                if (fq == 0) red[wc * 256 + ai * 128 + wr * 64 + m * 16 + fr] = s;
            }
        asm volatile("s_waitcnt lgkmcnt(0)" ::: "memory"); __builtin_amdgcn_s_barrier(); asm volatile("" ::: "memory");
        { const int t = (wr * 4 + wc) * 64 + fq * 16 + fr;
          if (t < 256) rowsq[(size_t)(u.pm * 256 + t) * 4 + u.pn] = (red[t] + red[256 + t]) + (red[512 + t] + red[768 + t]); }
        asm volatile("s_waitcnt lgkmcnt(0)" ::: "memory"); __builtin_amdgcn_s_barrier(); asm volatile("" ::: "memory");
    }
};

struct EpiFfn {
    static constexpr bool PERM = true, ACCUM = false;
    bf16_t* H; const float* rowsq; const float* sW;
    __device__ __forceinline__ void operator()(f32x4 (&acc)[2][2][4][2], const Unit& u, int wr, int wc, int fr, int fq) const {
        const int row0 = u.pm * 256 + wr * 64 + fr, b = u.pm >> 4, colp = u.pn * 256 + wc * 32 + 8 * fq, hcol = u.pn * 128 + wc * 32 + 8 * fq;
        const float* swp = sW + b * N13 + colp;
        f32x4 sa[2], sb[2];
#pragma unroll
        for (int n = 0; n < 2; ++n) { sa[n] = *(const f32x4*)(swp + 4 * n); sb[n] = *(const f32x4*)(swp + 128 + 4 * n); }
        float rq[2][4];
#pragma unroll
        for (int ai = 0; ai < 2; ++ai)
#pragma unroll
            for (int m = 0; m < 4; ++m) { const f32x4 p = *(const f32x4*)(rowsq + (size_t)(row0 + ai * 128 + m * 16) * 4); rq[ai][m] = (p[0] + p[1]) + (p[2] + p[3]); }
#pragma unroll
        for (int ai = 0; ai < 2; ++ai)
#pragma unroll
            for (int m = 0; m < 4; ++m) {
                const int r = row0 + ai * 128 + m * 16;
                const float rs = __builtin_amdgcn_rsqf(rq[ai][m] * (1.0f / D) + EPS);
                f32x4 h[2];
#pragma unroll
                for (int n = 0; n < 2; ++n) {
                    const f32x4 a = acc[ai][0][m][n] * rs + sa[n], bb = acc[ai][1][m][n] * rs + sb[n];
#pragma unroll
                    for (int j = 0; j < 4; ++j) h[n][j] = (a[j] * bb[j]) * sig_from_e(__builtin_amdgcn_exp2f(a[j] * -LOG2E));
                }
                u32x4 w; w.x = cvt_pk_bf16(h[0][0], h[0][1]); w.y = cvt_pk_bf16(h[0][2], h[0][3]); w.z = cvt_pk_bf16(h[1][0], h[1][1]); w.w = cvt_pk_bf16(h[1][2], h[1][3]);
                *(u32x4*)(H + (size_t)r * NFF + hcol) = w;
            }
    }
};


#define XB_TMO      128
#define XB_XCNT(j)  (256  + 64 * (j))
#define XB_XSUB(j)  (1280 + 64 * (j))
#define XB_XGEN(j)  (2304 + 64 * (j))
#define XB_TOP      3328
#define XB_TOPGEN   3392
#define XCD_BAR_WORDS 3456
#define XB_SPIN_CAP (1u << 22)
__device__ __forceinline__ unsigned xb_ld(unsigned* p)              { return __hip_atomic_load(p, __ATOMIC_RELAXED, __HIP_MEMORY_SCOPE_AGENT); }
__device__ __forceinline__ unsigned xb_add(unsigned* p, unsigned v) { return __hip_atomic_fetch_add(p, v, __ATOMIC_RELAXED, __HIP_MEMORY_SCOPE_AGENT); }
__device__ __forceinline__ unsigned xb_xcc_id() { return (unsigned)__builtin_amdgcn_s_getreg((3 << 11) | 20) & 0xFu; }
#define XB_SPIN(cond, bar) do { unsigned _sp = 0; while (cond) { __builtin_amdgcn_s_sleep(1); \
    if ((++_sp & 255u) == 0u) { if (xb_ld(&(bar)[XB_TMO])) break; if (_sp > XB_SPIN_CAP) { atomicAdd(&(bar)[XB_TMO], 1u); break; } } } } while (0)
struct XcdBarrier { unsigned* bar; unsigned x; volatile LAS unsigned* st; };
__device__ __forceinline__ XcdBarrier xcd_barrier_post(unsigned* bar, volatile LAS unsigned* st) {
    XcdBarrier b; b.bar = bar; b.x = xb_xcc_id(); b.st = st;
    if (threadIdx.x == 0) (void)xb_add(&bar[XB_XCNT(b.x)], 1u);
    return b;
}
__device__ __forceinline__ void xcd_barrier_complete(unsigned* bar, unsigned x, unsigned& nloc, unsigned& nx) {
    const unsigned G = gridDim.x * gridDim.y * gridDim.z;
    unsigned sum, cnt, mine, sp = 0u;
    for (;;) {
        sum = 0u; cnt = 0u; mine = 0u;
#pragma unroll
        for (unsigned j = 0; j < 16; ++j) { const unsigned c = xb_ld(&bar[XB_XCNT(j)]); sum += c; cnt += (c > 0u) ? 1u : 0u; mine = (j == x) ? c : mine; }
        if (sum == G) break;
        __builtin_amdgcn_s_sleep(1);
        if ((++sp & 255u) == 0u) { if (xb_ld(&bar[XB_TMO])) break; if (sp > XB_SPIN_CAP) { atomicAdd(&bar[XB_TMO], 1u); break; } }
    }
    nloc = mine > 0u ? mine : 1u; nx = cnt > 0u ? cnt : 1u;
}
__device__ __forceinline__ void xcd_barrier(const XcdBarrier& b) {
    asm volatile("s_waitcnt vmcnt(0)" ::: "memory");
    __syncthreads();
    if (threadIdx.x == 0) {
        unsigned* bar = b.bar;
        __builtin_amdgcn_s_waitcnt(0);
        unsigned nloc = b.st[0], nx = b.st[1];
        if (nloc == 0u) { xcd_barrier_complete(bar, b.x, nloc, nx); b.st[0] = nloc; b.st[1] = nx; }
        const unsigned old = xb_add(&bar[XB_XSUB(b.x)], 1u);
        const unsigned gen = old / nloc;
        if (old + 1u == (gen + 1u) * nloc) {
            __builtin_amdgcn_fence(__ATOMIC_RELEASE, "agent");
            asm volatile("s_waitcnt vmcnt(0)" ::: "memory");
            const unsigned og = xb_add(&bar[XB_TOP], 1u);
            const unsigned tg = og / nx;
            if (og + 1u == (tg + 1u) * nx) xb_add(&bar[XB_TOPGEN], 1u);
            else XB_SPIN(xb_ld(&bar[XB_TOPGEN]) == tg, bar);
            __builtin_amdgcn_fence(__ATOMIC_ACQUIRE, "agent");
            xb_add(&bar[XB_XGEN(b.x)], 1u);
            asm volatile("s_waitcnt vmcnt(0)" ::: "memory");
        } else {
            XB_SPIN(xb_ld(&bar[XB_XGEN(b.x)]) == gen, bar);
            __builtin_amdgcn_fence(__ATOMIC_ACQUIRE, "agent");
            asm volatile("s_waitcnt vmcnt(0)" ::: "memory");
        }
    }
    __syncthreads();
}

struct Args { const float* in[21]; float* out; unsigned char* ws; };
enum { I_X = 0, I_C, I_WMOD, I_BMOD, I_GMIX, I_WIN, I_LNG, I_LNB, I_WS, I_BS, I_WPA, I_POOLW, I_POOLS, I_WPB, I_CONVW, I_WPC, I_WO, I_GFFN, I_W13, I_W2, I_GFINAL };

__device__ __forceinline__ void transpose_item(const float* W, int ldw, int k0, int n0, bf16_t* dst, int ldd, int drow0, int dk0, LAS float* scr, int lane) {
    float tv[32];
    const float* wsrc = W + (size_t)(k0 + (lane >> 5)) * ldw + n0 + (lane & 31);
#pragma unroll
    for (int i = 0; i < 32; ++i) tv[i] = wsrc[(size_t)(2 * i) * ldw];
#pragma unroll
    for (int i = 0; i < 32; ++i) { const int kk = 2 * i + (lane >> 5); scr[kk * 33 + (lane & 31)] = tv[i]; }
    asm volatile("s_waitcnt vmcnt(0) lgkmcnt(0)" ::: "memory");
    const int c = lane & 7;
#pragma unroll
    for (int j = 0; j < 4; ++j) { const int n = (lane >> 3) + 8 * j; const LAS float* s = scr + (8 * c) * 33 + n;
        u32x4 o; o.x = cvt_pk_bf16(s[0 * 33], s[1 * 33]); o.y = cvt_pk_bf16(s[2 * 33], s[3 * 33]); o.z = cvt_pk_bf16(s[4 * 33], s[5 * 33]); o.w = cvt_pk_bf16(s[6 * 33], s[7 * 33]);
        *(u32x4*)(dst + (size_t)(drow0 + n) * ldd + dk0 + k0 + 8 * c) = o; }
    asm volatile("s_waitcnt lgkmcnt(0)" ::: "memory");
}

__device__ __forceinline__ void gemv64(const LAS float* vT, LAS float* red, const float* W, int ldw, int n0, int wave, int lane, int tid, float (&res)[2]) {
    float acc[16];
#pragma unroll
    for (int b = 0; b < 16; ++b) acc[b] = 0.f;
    const float* wp = W + (size_t)(wave * 128) * ldw + n0 + lane;
    const LAS f32x4* vp = (const LAS f32x4*)(vT + wave * 128 * 16);
#pragma unroll 16
    for (int kk = 0; kk < 128; ++kk) {
        const float wv = wp[(size_t)kk * ldw];
        const f32x4 v0 = vp[kk * 4 + 0], v1 = vp[kk * 4 + 1], v2 = vp[kk * 4 + 2], v3 = vp[kk * 4 + 3];
        acc[0] += v0[0] * wv; acc[1] += v0[1] * wv; acc[2] += v0[2] * wv; acc[3] += v0[3] * wv;
        acc[4] += v1[0] * wv; acc[5] += v1[1] * wv; acc[6] += v1[2] * wv; acc[7] += v1[3] * wv;
        acc[8] += v2[0] * wv; acc[9] += v2[1] * wv; acc[10] += v2[2] * wv; acc[11] += v2[3] * wv;
        acc[12] += v3[0] * wv; acc[13] += v3[1] * wv; acc[14] += v3[2] * wv; acc[15] += v3[3] * wv;
    }
#pragma unroll
    for (int b = 0; b < 16; ++b) red[(wave * 16 + b) * 64 + lane] = acc[b];
    __syncthreads();
#pragma unroll
    for (int r = 0; r < 2; ++r) { const int idx = tid + 512 * r, b = idx >> 6, n = idx & 63; float s = 0.f;
#pragma unroll
        for (int w = 0; w < 8; ++w) s += red[(w * 16 + b) * 64 + n];
        res[r] = s; }
    __syncthreads();
}

__global__ void __launch_bounds__(512, 2) fwd_megakernel(Args a) {
    extern __shared__ __attribute__((aligned(16))) unsigned char lds_raw[];
    LAS unsigned char* lds = (LAS unsigned char*)lds_raw;
    cg::grid_group grid = cg::this_grid();
    int tid, lane, wave, gw; const int G = gridDim.x, bid = blockIdx.x, NGW = G * 8;
#define RELOAD_IDS() do { tid = threadIdx.x; asm volatile("" : "+v"(tid)); lane = tid & 63; wave = __builtin_amdgcn_readfirstlane(tid >> 6); gw = bid * 8 + wave; } while (0)
    RELOAD_IDS();
    unsigned char* ws = a.ws;
    volatile LAS unsigned* MISC = (volatile LAS unsigned*)(lds + 131072);
    if (tid < 64) MISC[tid] = 0u;
    __syncthreads();
    const XcdBarrier xbar = xcd_barrier_post((unsigned*)(ws + WS_BAR), MISC + 8);
#define GRID_SYNC() xcd_barrier(xbar)

    bf16_t* ZA = (bf16_t*)(ws + WS_ZA); bf16_t* ZG = (bf16_t*)(ws + WS_ZG); bf16_t* Y = (bf16_t*)(ws + WS_Y); bf16_t* MG = (bf16_t*)(ws + WS_MG);
    bf16_t* XG = (bf16_t*)(ws + WS_XG); bf16_t* Hb = (bf16_t*)(ws + WS_H);
    bf16_t* WIN = (bf16_t*)(ws + WS_WIN); bf16_t* WP = (bf16_t*)(ws + WS_WP); bf16_t* WO = (bf16_t*)(ws + WS_WO); bf16_t* W13 = (bf16_t*)(ws + WS_W13); bf16_t* W2 = (bf16_t*)(ws + WS_W2);
    float* MOD = (float*)(ws + WS_MOD); float* GM1 = (float*)(ws + WS_GM1); float* GM2 = (float*)(ws + WS_GM2); float* SW1 = (float*)(ws + WS_SW1); float* SW2 = (float*)(ws + WS_SW2);
    float* RSQ1 = (float*)(ws + WS_RSQ1); float* RSQ2 = (float*)(ws + WS_RSQ2); bf16_t* WSM = (bf16_t*)(ws + WS_WSM);
    float* XF = (float*)(ws + WS_XF); bf16_t* X16 = (bf16_t*)a.out;

    for (int rep_ = 0; rep_ < REP_P0; ++rep_) {
{
        LAS float* vT = (LAS float*)lds; LAS float* red = (LAS float*)(lds + 65536);
        const float* c = a.in[I_C];
        for (int idx = tid; idx < 16 * D; idx += 512) { const int b = idx >> 10, k = idx & 1023; vT[k * 16 + b] = fsilu(c[idx]); }
        __syncthreads();
        for (int task = bid; task < 4 * 96; task += G) {
            const int l = task / 96, n0 = (task % 96) * 64;
            float res[2];
            gemv64(vT, red, a.in[I_WMOD] + (size_t)l * D * NMOD, NMOD, n0, wave, lane, tid, res);
#pragma unroll
            for (int r = 0; r < 2; ++r) { const int idx = tid + 512 * r, b = idx >> 6, n = n0 + (idx & 63);
                const float v = res[r] + a.in[I_BMOD][l * NMOD + n];
                MOD[(l * 16 + b) * NMOD + n] = v;
                if (n >= 1024 && n < 2048) GM1[(l * 16 + b) * D + n - 1024] = a.in[I_GMIX][l * D + n - 1024] * (1.0f + v);
                if (n >= 4096 && n < 5120) GM2[(l * 16 + b) * D + n - 4096] = a.in[I_GFFN][l * D + n - 4096] * (1.0f + v);
            }
        }
        __syncthreads();
        LAS float* scr = (LAS float*)(lds + wave * 16384);
        constexpr int IT_IN = 16 * 192, IT_PA = 8 * 32, IT_PC = 8 * 32, IT_O = 16 * 32, IT_13 = 16 * 176, IT_2 = 44 * 32, IT_L = IT_IN + IT_PA + IT_PC + IT_O + IT_13 + IT_2;
        for (int it = gw; it < 4 * IT_L; it += NGW) {
            const int l = it / IT_L; int r = it - l * IT_L;
            if (r < IT_IN) { const int kb = r / 192, nb = r % 192; const int n0 = nb * 32; int drow = n0;
                if (n0 >= 2048 && n0 < 3072) { const int c = n0 - 2048, isb = c >= 512, cc = c & 511; drow = 2048 + (cc >> 7) * 256 + isb * 128 + (cc & 127); }
                transpose_item(a.in[I_WIN] + (size_t)l * D * NIN, NIN, kb * 64, n0, WIN + l * E_WIN, D, drow, 0, scr, lane); continue; } r -= IT_IN;
            if (r < IT_PA) { const int kb = r / 32, nb = r % 32; transpose_item(a.in[I_WPA] + (size_t)l * 512 * D, D, kb * 64, nb * 32, WP + l * E_WP, KP, nb * 32, 0, scr, lane); continue; } r -= IT_PA;
            if (r < IT_PC) { const int kb = r / 32, nb = r % 32; transpose_item(a.in[I_WPC] + (size_t)l * 512 * D, D, kb * 64, nb * 32, WP + l * E_WP, KP, nb * 32, 1024, scr, lane); continue; } r -= IT_PC;
            if (r < IT_O) { const int kb = r / 32, nb = r % 32; transpose_item(a.in[I_WO] + (size_t)l * D * D, D, kb * 64, nb * 32, WO + l * E_WO, D, nb * 32, 0, scr, lane); continue; } r -= IT_O;
            if (r < IT_13) { const int kb = r / 176, nb = r % 176; const int n0 = nb * 32; const int j = n0 % NFF, isb = n0 >= NFF; const int drow = (j / 128) * 256 + isb * 128 + (j % 128);
                transpose_item(a.in[I_W13] + (size_t)l * D * N13, N13, kb * 64, n0, W13 + l * E_W13, D, drow, 0, scr, lane); continue; } r -= IT_13;
            { const int kb = r / 32, nb = r % 32; transpose_item(a.in[I_W2] + (size_t)l * NFF * D, D, kb * 64, nb * 32, W2 + l * E_W2, NFF, nb * 32, 0, scr, lane); }
        }
        for (int t = gw; t < 4096; t += NGW) {
            const int l = t >> 10, g = (t >> 8) & 3, cb = (t >> 4) & 15, nbk = t & 15, n = nbk * 64 + lane, c0 = cb * 8;
            const float* pw = a.in[I_POOLW] + (size_t)((l * 4 + g) * 128 + c0) * 128;
            const float* ps = a.in[I_POOLS] + l * 512 + g * 128;
            const float* wb = a.in[I_WPB] + (size_t)(l * 512 + g * 128) * D + n;
            float acc[8];
#pragma unroll
            for (int i = 0; i < 8; ++i) acc[i] = 0.f;
#pragma unroll 32
            for (int d = 0; d < 128; ++d) { const float tv = ps[d] * wb[(size_t)d * D];
#pragma unroll
                for (int i = 0; i < 8; ++i) acc[i] += pw[i * 128 + d] * tv; }
            u32x4 o; o.x = cvt_pk_bf16(acc[0], acc[1]); o.y = cvt_pk_bf16(acc[2], acc[3]); o.z = cvt_pk_bf16(acc[4], acc[5]); o.w = cvt_pk_bf16(acc[6], acc[7]);
            *(u32x4*)(WP + l * E_WP + (size_t)n * KP + 512 + g * 128 + c0) = o;
        }
        for (int idx = bid * 512 + tid; idx < 4 * 4 * 128 * 128; idx += G * 512) { const int s = idx & 127, t = (idx >> 7) & 127; const float w = a.in[I_WS][idx];
            WSM[idx] = (s <= t) ? (bf16_t)(cvt_pk_bf16(w, 0.f) & 0xffffu) : (bf16_t)0; }
    }
    if (rep_ == 0) grid.sync(); else GRID_SYNC();
}
    for (int rep_ = 0; rep_ < REP_P0; ++rep_) {
{ RELOAD_IDS();
        {
            const int wig = gw & 255, gstep = (NGW >> 8) > 0 ? (NGW >> 8) : 1;
            for (int grp = gw >> 8; grp < 8 && (gw >> 8) < gstep; grp += gstep) { const int l = grp >> 1, which = grp & 1;
                const int li = lane & 15, lq = lane >> 4;
                const float* sh = MOD + (size_t)(l * 16 + li) * NMOD + (which ? 3072 : 0) + 8 * lq;
                bf16x8 af[32];
#pragma unroll
                for (int ks = 0; ks < 32; ++ks) { const f32x4 s0 = *(const f32x4*)(sh + 32 * ks), s1 = *(const f32x4*)(sh + 32 * ks + 4);
                    u32x4 p; p.x = cvt_pk_bf16(s0[0], s0[1]); p.y = cvt_pk_bf16(s0[2], s0[3]); p.z = cvt_pk_bf16(s1[0], s1[1]); p.w = cvt_pk_bf16(s1[2], s1[3]); af[ks] = __builtin_bit_cast(bf16x8, p); }
                const bf16_t* Wt = which ? W13 + l * E_W13 : WIN + l * E_WIN; const int Nw = which ? N13 : NIN; float* SW = which ? SW2 + l * 16 * N13 : SW1 + l * 16 * NIN;
                for (int tile = wig; tile < Nw / 16; tile += 256) {
                    const bf16_t* wrow = Wt + (size_t)(tile * 16 + li) * D + 8 * lq;
                    f32x4 acc = {0.f, 0.f, 0.f, 0.f};
#pragma unroll
                    for (int kb = 0; kb < 2; ++kb) {
                        bf16x8 bfr[16];
#pragma unroll
                        for (int ks = 0; ks < 16; ++ks) bfr[ks] = *(const bf16x8*)(wrow + 32 * (16 * kb + ks));
#pragma unroll
                        for (int ks = 0; ks < 16; ++ks) acc = __builtin_amdgcn_mfma_f32_16x16x32_bf16(af[16 * kb + ks], bfr[ks], acc, 0, 0, 0);
                    }
#pragma unroll
                    for (int r = 0; r < 4; ++r) SW[(size_t)(4 * lq + r) * Nw + tile * 16 + li] = acc[r];
                }
            }
        }
        const float* x = a.in[I_X];
        for (int rowb = gw; rowb < M; rowb += 4 * NGW) {
            f32x4 v[4][4];
#pragma unroll
            for (int q = 0; q < 4; ++q) { const int row = rowb + q * NGW; const f32x4* xr = (const f32x4*)(x + (size_t)row * D) + lane;
#pragma unroll
                for (int j = 0; j < 4; ++j) v[q][j] = xr[64 * j]; }
#pragma unroll
            for (int q = 0; q < 4; ++q) {
                const int row = rowb + q * NGW, b = row >> 12; const f32x4* gr = (const f32x4*)(GM1 + b * D) + lane;
                float s = 0.f;
#pragma unroll
                for (int j = 0; j < 4; ++j) s += (v[q][j][0] * v[q][j][0] + v[q][j][1] * v[q][j][1]) + (v[q][j][2] * v[q][j][2] + v[q][j][3] * v[q][j][3]);
                s = wave_sum(s);
                if (lane == 0) *(f32x4*)(RSQ1 + (size_t)row * 4) = (f32x4){s, 0.f, 0.f, 0.f};
                u32x2* o = (u32x2*)(XG + (size_t)row * D) + lane; u32x2* ox = (u32x2*)(X16 + (size_t)row * D) + lane;
#pragma unroll
                for (int j = 0; j < 4; ++j) { const f32x4 g = v[q][j] * gr[64 * j]; u32x2 w; w.x = cvt_pk_bf16(g[0], g[1]); w.y = cvt_pk_bf16(g[2], g[3]); o[64 * j] = w;
                    u32x2 wx; wx.x = cvt_pk_bf16(v[q][j][0], v[q][j][1]); wx.y = cvt_pk_bf16(v[q][j][2], v[q][j][3]); ox[64 * j] = wx; }
            }
        }
    }
    GRID_SYNC();
}

#pragma unroll 1
    for (int l = 0; l < DEPTH; ++l) {
#pragma unroll 1
        for (int half = 0; half < 2; ++half) {
            const int row0 = half * MH;
            for (int rep_ = 0; rep_ < REP_P1; ++rep_) {
{ RELOAD_IDS();
                pg8::Gemm g{XG + (size_t)row0 * D, WIN + l * E_WIN, D, D, D};
                pg8::Order<1> S; S.init(MH, NIN, G, bid);
                EpiIn E{ZA, ZG, RSQ1, SW1 + l * 16 * NIN, row0};
                pg8::gemm_phase<EpiIn, pg8::Order<1>, true, true>(lds, g, S, E);
            }
            GRID_SYNC();
}
            for (int rep_ = 0; rep_ < REP_P2; ++rep_) {
{ RELOAD_IDS();
                for (int ch = bid; ch < MH / 128; ch += G) {
                    const int r0 = ch * 128;
                    __syncthreads();
                    {
                        const int c8 = lane * 8;
                        u32x4 wv16[16];
#pragma unroll
                        for (int i = 0; i < 16; ++i) wv16[i] = *(const u32x4*)(ZA + (size_t)(r0 + wave * 16 + i) * ZW + 512 + c8);
                        const f32x4 g0 = *(const f32x4*)(a.in[I_LNG] + l * 512 + c8), g1 = *(const f32x4*)(a.in[I_LNG] + l * 512 + c8 + 4);
                        const f32x4 b0 = *(const f32x4*)(a.in[I_LNB] + l * 512 + c8), b1 = *(const f32x4*)(a.in[I_LNB] + l * 512 + c8 + 4);
#pragma unroll
                        for (int i = 0; i < 16; ++i) {
                            const int r = wave * 16 + i;
                            const u32x4 w = wv16[i];
                            const float f0 = bflo(w.x), f1 = bfhi(w.x), f2 = bflo(w.y), f3 = bfhi(w.y), f4 = bflo(w.z), f5 = bfhi(w.z), f6 = bflo(w.w), f7 = bfhi(w.w);
                            const float mean = wave_sum(((f0 + f1) + (f2 + f3)) + ((f4 + f5) + (f6 + f7))) * (1.0f / 512.0f);
                            const float d0 = f0 - mean, d1 = f1 - mean, d2 = f2 - mean, d3 = f3 - mean, d4 = f4 - mean, d5 = f5 - mean, d6 = f6 - mean, d7 = f7 - mean;
                            const float var = wave_sum(((d0 * d0 + d1 * d1) + (d2 * d2 + d3 * d3)) + ((d4 * d4 + d5 * d5) + (d6 * d6 + d7 * d7))) * (1.0f / 512.0f);
                            const float rs = __builtin_amdgcn_rsqf(var + EPS);
                            u32x4 p; p.x = cvt_pk_bf16(d0 * rs * g0[0] + b0[0], d1 * rs * g0[1] + b0[1]); p.y = cvt_pk_bf16(d2 * rs * g0[2] + b0[2], d3 * rs * g0[3] + b0[3]);
                            p.z = cvt_pk_bf16(d4 * rs * g1[0] + b1[0], d5 * rs * g1[1] + b1[1]); p.w = cvt_pk_bf16(d6 * rs * g1[2] + b1[2], d7 * rs * g1[3] + b1[3]);
                            *(LAS u32x4*)(lds + r * 1024 + ((lane * 16) ^ (((r >> 3) & 1) << 6))) = p;
                        }
                    }
                    __syncthreads();
                    const int li = lane & 15, lq = lane >> 4;
#pragma unroll 1
                    for (int h = 0; h < 4; ++h) {
                        const int d0 = h * 128 + wave * 16;
                        const bf16_t* wsm = WSM + (size_t)((l * 4 + h) * 128) * 128;
                        const float* bs = a.in[I_BS] + (l * 4 + h) * 128;
                        u32x2 uwv[8]; float bsvv[8];
#pragma unroll
                        for (int rt = 0; rt < 8; ++rt) { const int t = 16 * rt + li; bsvv[rt] = bs[t]; uwv[rt] = *(const u32x2*)(ZA + (size_t)(r0 + t) * ZW + d0 + 4 * lq); }
                        bf16x8 vf[4];
                        const LAS bf16_t* vl = (const LAS bf16_t*)(lds + 8 * lq * 1024 + (((d0 + li) * 2) ^ ((lq & 1) << 6)));
#pragma unroll
                        for (int ks = 0; ks < 4; ++ks) {
                            unsigned e[8];
#pragma unroll
                            for (int j = 0; j < 8; ++j) e[j] = vl[(32 * ks + j) * 512];
                            u32x4 p; p.x = e[0] | (e[1] << 16); p.y = e[2] | (e[3] << 16); p.z = e[4] | (e[5] << 16); p.w = e[6] | (e[7] << 16);
                            vf[ks] = __builtin_bit_cast(bf16x8, p);
                        }
#pragma unroll
                        for (int rt = 0; rt < 8; ++rt) {
                            f32x4 acc = {0.f, 0.f, 0.f, 0.f};
                            bf16x8 wf[4];
#pragma unroll
                            for (int ks = 0; ks < 4; ++ks) if (32 * ks <= 16 * rt + 15) wf[ks] = *(const bf16x8*)(wsm + (size_t)(16 * rt + li) * 128 + 32 * ks + 8 * lq);
#pragma unroll
                            for (int ks = 0; ks < 4; ++ks) if (32 * ks <= 16 * rt + 15) acc = __builtin_amdgcn_mfma_f32_16x16x32_bf16(vf[ks], wf[ks], acc, 0, 0, 0);
                            const int t = 16 * rt + li; const float bsv = bsvv[rt];
                            const u32x2 uw = uwv[rt];
                            const float o0 = bflo(uw.x) * (acc[0] + bsv), o1 = bfhi(uw.x) * (acc[1] + bsv), o2 = bflo(uw.y) * (acc[2] + bsv), o3 = bfhi(uw.y) * (acc[3] + bsv);
                            u32x2 ow; ow.x = cvt_pk_bf16(o0, o1); ow.y = cvt_pk_bf16(o2, o3);
                            *(u32x2*)(Y + (size_t)(r0 + t) * KP + d0 + 4 * lq) = ow;
                        }
                    }
                }
                const int NT = MH / 32;
                for (int task = gw; task < 2 * NT; task += NGW) {
                    const int c8 = lane * 8;
                    if (task < NT) {
                        const int t0 = task * 32, tp0 = (row0 + t0) & (SEQ - 1), win = 2 << (lane >> 4);
                        const bf16_t* xb = ZA + 1024 + c8;
                        float S[8];
#pragma unroll
                        for (int j = 0; j < 8; ++j) S[j] = 0.f;
                        {
                            u32x4 hw[16];
#pragma unroll
                            for (int i = 1; i <= 16; ++i) { const int tt = (tp0 - i >= 0) ? t0 - i : t0; hw[i - 1] = *(const u32x4*)(xb + (size_t)tt * ZW); }
#pragma unroll
                            for (int i = 1; i <= 16; ++i) { const float mk = (i <= win && tp0 - i >= 0) ? 1.0f : 0.0f; const u32x4 w = hw[i - 1];
                                S[0] += mk * bflo(w.x); S[1] += mk * bfhi(w.x); S[2] += mk * bflo(w.y); S[3] += mk * bfhi(w.y); S[4] += mk * bflo(w.z); S[5] += mk * bfhi(w.z); S[6] += mk * bflo(w.w); S[7] += mk * bfhi(w.w); }
                        }
#pragma unroll 8
                        for (int i = 0; i < 32; ++i) {
                            const int t = t0 + i, tp = tp0 + i;
                            const u32x4 w = *(const u32x4*)(xb + (size_t)t * ZW);
                            float xv[8] = {bflo(w.x), bfhi(w.x), bflo(w.y), bfhi(w.y), bflo(w.z), bfhi(w.z), bflo(w.w), bfhi(w.w)};
#pragma unroll
                            for (int j = 0; j < 8; ++j) S[j] += xv[j];
                            if (tp - win >= 0) {
                                const u32x4 o = *(const u32x4*)(xb + (size_t)(t - win) * ZW);
                                S[0] -= bflo(o.x); S[1] -= bfhi(o.x); S[2] -= bflo(o.y); S[3] -= bfhi(o.y); S[4] -= bflo(o.z); S[5] -= bfhi(o.z); S[6] -= bflo(o.w); S[7] -= bfhi(o.w);
                            }
                            const int cnt = (tp + 1 < win) ? tp + 1 : win; const float inv = 1.0f / (float)cnt;
                            u32x4 p; p.x = cvt_pk_bf16(S[0] * inv - xv[0], S[1] * inv - xv[1]); p.y = cvt_pk_bf16(S[2] * inv - xv[2], S[3] * inv - xv[3]);
                            p.z = cvt_pk_bf16(S[4] * inv - xv[4], S[5] * inv - xv[5]); p.w = cvt_pk_bf16(S[6] * inv - xv[6], S[7] * inv - xv[7]);
                            *(u32x4*)(Y + (size_t)t * KP + 512 + c8) = p;
                        }
                    } else {
                        const int t0 = (task - NT) * 32, tp0 = (row0 + t0) & (SEQ - 1);
                        const float* cw = a.in[I_CONVW] + l * 3 * 512 + c8;
                        float w0[8], w1[8], w2[8], z1[8], z2[8];
#pragma unroll
                        for (int j = 0; j < 8; ++j) { w0[j] = cw[j]; w1[j] = cw[512 + j]; w2[j] = cw[1024 + j]; z1[j] = 0.f; z2[j] = 0.f; }
                        const bf16_t* zb = ZA + c8;
                        if (tp0 >= 1) { const u32x4 zw = *(const u32x4*)(zb + (size_t)(t0 - 1) * ZW + 2048);
                            z1[0] = bflo(zw.x); z1[1] = bfhi(zw.x); z1[2] = bflo(zw.y); z1[3] = bfhi(zw.y); z1[4] = bflo(zw.z); z1[5] = bfhi(zw.z); z1[6] = bflo(zw.w); z1[7] = bfhi(zw.w); }
                        if (tp0 >= 2) { const u32x4 zw = *(const u32x4*)(zb + (size_t)(t0 - 2) * ZW + 2048);
                            z2[0] = bflo(zw.x); z2[1] = bfhi(zw.x); z2[2] = bflo(zw.y); z2[3] = bfhi(zw.y); z2[4] = bflo(zw.z); z2[5] = bfhi(zw.z); z2[6] = bflo(zw.w); z2[7] = bfhi(zw.w); }
#pragma unroll 8
                        for (int i = 0; i < 32; ++i) {
                            const size_t ro = (size_t)(t0 + i) * ZW;
                            const u32x4 bgw = *(const u32x4*)(zb + ro + 1536), zw = *(const u32x4*)(zb + ro + 2048);
                            float z0[8] = {bflo(zw.x), bfhi(zw.x), bflo(zw.y), bfhi(zw.y), bflo(zw.z), bfhi(zw.z), bflo(zw.w), bfhi(zw.w)};
                            float bg[8] = {bflo(bgw.x), bfhi(bgw.x), bflo(bgw.y), bfhi(bgw.y), bflo(bgw.z), bfhi(bgw.z), bflo(bgw.w), bfhi(bgw.w)};
                            float o[8];
#pragma unroll
                            for (int j = 0; j < 8; ++j) { o[j] = bg[j] * (w0[j] * z2[j] + w1[j] * z1[j] + w2[j] * z0[j]); z2[j] = z1[j]; z1[j] = z0[j]; }
                            u32x4 p; p.x = cvt_pk_bf16(o[0], o[1]); p.y = cvt_pk_bf16(o[2], o[3]); p.z = cvt_pk_bf16(o[4], o[5]); p.w = cvt_pk_bf16(o[6], o[7]);
                            *(u32x4*)(Y + (size_t)(t0 + i) * KP + 1024 + c8) = p;
                        }
                    }
                }
            }
            GRID_SYNC();
}
            for (int rep_ = 0; rep_ < REP_P3; ++rep_) {
{ RELOAD_IDS();
                pg8::Gemm g{Y, WP + l * E_WP, KP, KP, 512};
                pg8::Order<3> S; S.init(MH, D, G, bid);
                EpiMerge E{ZG, MG, row0};
                pg8::gemm_phase<EpiMerge, pg8::Order<3>, true, true>(lds, g, S, E);
            }
            GRID_SYNC();
}
        }
        for (int rep_ = REP_P4 - 1; rep_ >= 0; --rep_) { RELOAD_IDS();
            pg8::Gemm g{MG, WO + l * E_WO, D, D, D};
            pg8::Order<1> S; S.init(M, D, G, bid);
            EpiRes E{X16, (void*)X16, true, MOD + l * 16 * NMOD + 2048, GM2 + l * 16 * D, RSQ2, XG, (LAS float*)(lds + 131072 + 1024)};
            pg8::gemm_phase<EpiRes, pg8::Order<1>, true, true>(lds, g, S, E);
        GRID_SYNC();
        }
        for (int rep_ = 0; rep_ < REP_P5; ++rep_) {
{ RELOAD_IDS();
            pg8::Gemm g{XG, W13 + l * E_W13, D, D, D};
            pg8::Order<1> S; S.init(M, N13, G, bid);
            EpiFfn E{Hb, RSQ2, SW2 + l * 16 * N13};
            pg8::gemm_phase<EpiFfn, pg8::Order<1>, true, true>(lds, g, S, E);
        }
        GRID_SYNC();
}
        for (int rep_ = REP_P6 - 1; rep_ >= 0; --rep_) { RELOAD_IDS();
            pg8::Gemm g{Hb, W2 + l * E_W2, NFF, NFF, NFF};
            pg8::Order<1> S; S.init(M, D, G, bid);
            EpiRes E{X16, (l + 1 < DEPTH) ? (void*)X16 : (void*)XF, l + 1 < DEPTH, MOD + l * 16 * NMOD + 5120, (l + 1 < DEPTH) ? GM1 + (l + 1) * 16 * D : nullptr, RSQ1, XG, (LAS float*)(lds + 131072 + 1024)};
            pg8::gemm_phase<EpiRes, pg8::Order<1>, true, true>(lds, g, S, E);
        GRID_SYNC();
        }
    }
    { RELOAD_IDS();
        const f32x4* gf = (const f32x4*)a.in[I_GFINAL] + lane;
        for (int rowb = gw; rowb < M; rowb += 4 * NGW) {
            f32x4 v[4][4], pq[4];
#pragma unroll
            for (int q = 0; q < 4; ++q) { const int row = rowb + q * NGW; const f32x4* xr = (const f32x4*)(XF + (size_t)row * D) + lane; pq[q] = *(const f32x4*)(RSQ1 + (size_t)row * 4);
#pragma unroll
                for (int j = 0; j < 4; ++j) v[q][j] = xr[64 * j]; }
#pragma unroll
            for (int q = 0; q < 4; ++q) { const int row = rowb + q * NGW;
                const float rs = __builtin_amdgcn_rsqf(((pq[q][0] + pq[q][1]) + (pq[q][2] + pq[q][3])) * (1.0f / D) + EPS);
                f32x4* orow = (f32x4*)(a.out + (size_t)row * D) + lane;
#pragma unroll
                for (int j = 0; j < 4; ++j) orow[64 * j] = v[q][j] * rs * gf[64 * j]; }
        }
    }
}

extern "C" void kernel_launch(void* const* d_in, const int* in_sizes, int n_in, void* d_out, int out_size, void* d_ws, size_t ws_size, hipStream_t stream) {
    static int grid = 0;
    if (grid == 0) {
        if (n_in != 21 || in_sizes[0] != M * D || out_size != M * D || ws_size < WS_BAR + BAR_BYTES) { fprintf(stderr, "kernel_launch: unexpected shapes / workspace (n_in %d, ws %zu)\n", n_in, ws_size); grid = -1; return; }
        int dev = 0, cus = 0, per_cu = 0;
        (void)hipGetDevice(&dev);
        (void)hipDeviceGetAttribute(&cus, hipDeviceAttributeMultiprocessorCount, dev);
        if (hipFuncSetAttribute((const void*)fwd_megakernel, hipFuncAttributeMaxDynamicSharedMemorySize, LDS_BYTES) != hipSuccess) { fprintf(stderr, "kernel_launch: hipFuncSetAttribute failed\n"); grid = -1; return; }
        if (hipOccupancyMaxActiveBlocksPerMultiprocessor(&per_cu, (const void*)fwd_megakernel, 512, LDS_BYTES) != hipSuccess || per_cu < 1) { fprintf(stderr, "kernel_launch: occupancy query gave %d\n", per_cu); per_cu = 1; }
        (void)hipGetLastError();
        grid = cus * 1;
        if (grid > 256) grid = 256;
    }
    if (grid < 0) return;
    if (hipMemsetAsync((char*)d_ws + WS_BAR, 0, BAR_BYTES, stream) != hipSuccess) { fprintf(stderr, "kernel_launch: memset failed\n"); return; }
    Args a{};
    for (int i = 0; i < 21; ++i) a.in[i] = (const float*)d_in[i];
    a.out = (float*)d_out; a.ws = (unsigned char*)d_ws;
    void* args[] = {&a};
    hipError_t e = hipLaunchCooperativeKernel((const void*)fwd_megakernel, dim3(grid), dim3(512), args, LDS_BYTES, stream);
    if (e != hipSuccess) fprintf(stderr, "kernel_launch: cooperative launch failed: %s (grid %d)\n", hipGetErrorString(e), grid);
}
```
